# Optimizing an MI355X kernel written in HIP

```python
import jax, jax.numpy as jnp
from jax import lax
import numpy as np

D_MODEL = 1024
BATCH = 2
SEQ = 8192
DEPTH = 2

HEAD_DIM = 64
ATT_HEADS = (D_MODEL // 2) // HEAD_DIM
ATT_WIDTH = ATT_HEADS * HEAD_DIM
DILATED_BRANCHES = ((128, 1), (512, 4), (2048, 16))
ATT_BLOCK = 128
CONV_WIDTH = D_MODEL // 4
CONV_K = 3
GLA_HEADS = 4
GLA_VAL_WIDTH = D_MODEL // 4
GLA_KEY_WIDTH = GLA_VAL_WIDTH // 2
GLA_DV = GLA_VAL_WIDTH // GLA_HEADS
GLA_DK = GLA_KEY_WIDTH // GLA_HEADS
GLA_GATE_RANK = 16
GLA_GATE_TAU = 16.0
GLA_CHUNK = 32
MIX_WIDTH = ATT_WIDTH + CONV_WIDTH + GLA_VAL_WIDTH
IN_WIDTHS = (ATT_WIDTH, ATT_WIDTH, ATT_WIDTH,
             CONV_WIDTH, CONV_WIDTH, CONV_WIDTH,
             GLA_KEY_WIDTH, GLA_KEY_WIDTH,
             GLA_VAL_WIDTH, GLA_VAL_WIDTH,
             GLA_GATE_RANK)
IN_TOTAL = sum(IN_WIDTHS)
D_FF_DENSE = 2816
N_EXPERTS = 8
TOP_K = 2
D_FF_EXPERT = 3584
ROPE_THETA = 10000.0
EPS = 1e-6
NEG = -1e30

kernel_name = "hybrid_dilated_conv_gla_moe_trunk"


def rmsnorm(x, g):
    xf = x.astype(jnp.float32)
    y = xf * lax.rsqrt(jnp.mean(xf * xf, axis=-1, keepdims=True) + EPS)
    return (y * g.astype(jnp.float32)).astype(x.dtype)


def rope_tables(seq, dim):
    inv = 1.0 / (ROPE_THETA ** (jnp.arange(0, dim, 2, dtype=jnp.float32) / dim))
    ang = jnp.arange(seq, dtype=jnp.float32)[:, None] * inv[None, :]
    return jnp.cos(ang), jnp.sin(ang)


def apply_rope(x, cos, sin):
    x1, x2 = jnp.split(x.astype(jnp.float32), 2, axis=-1)
    c = cos[None, :, None, :]
    s = sin[None, :, None, :]
    return jnp.concatenate([x1 * c - x2 * s, x1 * s + x2 * c], axis=-1)


def dilated_branch(q, k, v, window, dilation):
    b, s, h, d = q.shape
    n_back = window // dilation
    assert n_back <= ATT_BLOCK
    L = s // dilation
    nb = -(-L // ATT_BLOCK)
    Lp = nb * ATT_BLOCK

    def to_strided(t):
        t = t.reshape(b, L, dilation, h, d).transpose(0, 2, 3, 1, 4)
        t = jnp.pad(t, ((0, 0), (0, 0), (0, 0), (0, Lp - L), (0, 0)))
        return t.reshape(b, dilation, h, nb, ATT_BLOCK, d)

    def with_prev(t):
        prev = jnp.pad(t, ((0, 0), (0, 0), (0, 0), (1, 0), (0, 0), (0, 0)))[:, :, :, :-1]
        return jnp.concatenate([prev, t], axis=4)

    qs = to_strided(q)
    kk = with_prev(to_strided(k))
    vv = with_prev(to_strided(v))
    scores = jnp.einsum('brhnqd,brhnkd->brhnqk', qs, kk) * (d ** -0.5)
    blk = jnp.arange(nb)[:, None, None]
    qi = blk * ATT_BLOCK + jnp.arange(ATT_BLOCK)[None, :, None]
    ki = (blk - 1) * ATT_BLOCK + jnp.arange(2 * ATT_BLOCK)[None, None, :]
    diff = qi - ki
    valid = (diff >= 0) & (diff <= n_back) & (ki >= 0)
    scores = jnp.where(valid, scores, NEG)
    mx = jnp.max(scores, axis=-1)
    p = jnp.where(valid, jnp.exp(scores - mx[..., None]), 0.0)
    den = jnp.sum(p, axis=-1)
    num = jnp.einsum('brhnqk,brhnkd->brhnqd', p, vv)

    def from_strided(t):
        tail = t.shape[5:]
        t = t.reshape((b, dilation, h, Lp) + tail)[:, :, :, :L]
        perm = (0, 3, 1, 2) + tuple(range(4, t.ndim))
        return t.transpose(perm).reshape((b, s, h) + tail)

    return from_strided(num), from_strided(den), from_strided(mx)


def dilated_attention(q, k, v):
    outs = [dilated_branch(q, k, v, w, dl) for (w, dl) in DILATED_BRANCHES]
    m_all = jnp.max(jnp.stack([o[2] for o in outs]), axis=0)
    num = 0.0
    den = 0.0
    for n_i, d_i, m_i in outs:
        w_i = jnp.exp(m_i - m_all)
        num = num + w_i[..., None] * n_i
        den = den + w_i * d_i
    return num / den[..., None]


def short_gated_conv(gate_b, gate_c, hin, conv_w):
    u = gate_c * hin
    y = lax.conv_general_dilated(u, conv_w[:, None, :].astype(u.dtype), window_strides=(1,),
                                 padding=[(CONV_K - 1, 0)],
                                 dimension_numbers=('NWC', 'WIO', 'NWC'),
                                 feature_group_count=u.shape[-1])
    return gate_b * y


def gla(q, k, v, log_a, out_gate, norm_g):
    f32 = jnp.float32
    b, s, h, dk = q.shape
    dv = v.shape[-1]
    C = GLA_CHUNK
    n = s // C

    def chunk(t):
        return t.astype(f32).reshape(b, n, C, h, -1).transpose(0, 3, 1, 2, 4)

    qc = chunk(q) * (dk ** -0.5)
    kc, vc, ac = chunk(k), chunk(v), chunk(log_a)
    bcum = jnp.cumsum(ac, axis=3)
    causal = jnp.tril(jnp.ones((C, C), dtype=bool))[..., None]
    diff = bcum[:, :, :, :, None, :] - bcum[:, :, :, None, :, :]
    decay = jnp.where(causal, jnp.exp(jnp.minimum(diff, 0.0)), 0.0)
    attn = jnp.einsum('bhntk,bhnsk,bhntsk->bhnts', qc, kc, decay)
    o_intra = jnp.einsum('bhnts,bhnsv->bhntv', attn, vc)
    b_last = bcum[:, :, :, -1, :]
    k_to_end = kc * jnp.exp(b_last[:, :, :, None, :] - bcum)
    chunk_state = jnp.einsum('bhnsk,bhnsv->bhnkv', k_to_end, vc)

    def step(state, inp):
        a_last, upd = inp
        return jnp.exp(a_last)[..., None] * state + upd, state

    init = jnp.zeros((b, h, dk, dv), f32)
    _, s_prev = lax.scan(step, init, (jnp.moveaxis(b_last, 2, 0), jnp.moveaxis(chunk_state, 2, 0)))
    s_prev = jnp.moveaxis(s_prev, 0, 2)
    o_inter = jnp.einsum('bhntk,bhnkv->bhntv', qc * jnp.exp(bcum), s_prev)
    o = (o_intra + o_inter).transpose(0, 2, 3, 1, 4).reshape(b, s, h, dv)
    o = o * lax.rsqrt(jnp.mean(o * o, axis=-1, keepdims=True) + EPS)
    return o.reshape(b, s, h * dv) * norm_g.astype(f32) * jax.nn.silu(out_gate.astype(f32))


def hybrid_mixer(hn, w_in, w_gate_lr, b_gate_lr, conv_w, gla_norm, w_out, cos, sin):
    b, s, _ = hn.shape
    split_pts = [int(p) for p in np.cumsum(IN_WIDTHS)[:-1]]
    proj = hn @ w_in
    (q_a, k_a, v_a, c_b, c_c, c_h, g_q, g_k, g_v, g_o, g_z) = jnp.split(proj, split_pts, axis=-1)
    qa = apply_rope(q_a.reshape(b, s, ATT_HEADS, HEAD_DIM), cos, sin)
    ka = apply_rope(k_a.reshape(b, s, ATT_HEADS, HEAD_DIM), cos, sin)
    va = v_a.reshape(b, s, ATT_HEADS, HEAD_DIM).astype(jnp.float32)
    att = dilated_attention(qa, ka, va).reshape(b, s, ATT_WIDTH)
    cv = short_gated_conv(c_b, c_c, c_h, conv_w)
    log_a = jax.nn.log_sigmoid((g_z @ w_gate_lr + b_gate_lr).astype(jnp.float32)) / GLA_GATE_TAU
    gl = gla(g_q.reshape(b, s, GLA_HEADS, GLA_DK), g_k.reshape(b, s, GLA_HEADS, GLA_DK),
             g_v.reshape(b, s, GLA_HEADS, GLA_DV), log_a.reshape(b, s, GLA_HEADS, GLA_DK),
             g_o, gla_norm)
    mix = jnp.concatenate([att.astype(hn.dtype), cv.astype(hn.dtype), gl.astype(hn.dtype)], axis=-1)
    return mix @ w_out


def swiglu(h, wg, wu, wd):
    return (jax.nn.silu(h @ wg) * (h @ wu)) @ wd


def moe_swiglu(h, router, eg, eu, ed):
    b, s, d = h.shape
    t = h.reshape(b * s, d)
    logits = (t @ router).astype(jnp.float32)
    top_v, top_i = lax.top_k(logits, TOP_K)
    top_w = jax.nn.softmax(top_v, axis=-1)
    combine = jnp.sum(jax.nn.one_hot(top_i, N_EXPERTS, dtype=jnp.float32) * top_w[..., None], axis=1)
    out = jnp.zeros((b * s, d), jnp.float32)
    for e in range(N_EXPERTS):
        out = out + combine[:, e:e + 1] * swiglu(t, eg[e], eu[e], ed[e]).astype(jnp.float32)
    return out.astype(h.dtype).reshape(b, s, d)


def setup_inputs(seed: int = 0) -> dict:
    key = jax.random.key(seed)
    ks = jax.random.split(key, 20)
    n_dense = (DEPTH + 1) // 2
    n_moe = DEPTH // 2
    nrm = jax.random.normal
    f32 = jnp.float32
    return {
        "x": nrm(ks[0], (BATCH, SEQ, D_MODEL), f32),
        "mix_norm": 1.0 + 0.02 * nrm(ks[1], (DEPTH, D_MODEL), f32),
        "w_in": nrm(ks[2], (DEPTH, D_MODEL, IN_TOTAL), f32) * D_MODEL ** -0.5,
        "w_gate_lr": nrm(ks[3], (DEPTH, GLA_GATE_RANK, GLA_KEY_WIDTH), f32) * GLA_GATE_RANK ** -0.5,
        "b_gate_lr": 0.1 * nrm(ks[4], (DEPTH, GLA_KEY_WIDTH), f32),
        "conv_w": nrm(ks[5], (DEPTH, CONV_K, CONV_WIDTH), f32) * CONV_K ** -0.5,
        "gla_norm": 1.0 + 0.02 * nrm(ks[6], (DEPTH, GLA_VAL_WIDTH), f32),
        "w_out": nrm(ks[7], (DEPTH, MIX_WIDTH, D_MODEL), f32) * MIX_WIDTH ** -0.5,
        "ffn_norm": 1.0 + 0.02 * nrm(ks[8], (DEPTH, D_MODEL), f32),
        "dense_w_gate": nrm(ks[9], (n_dense, D_MODEL, D_FF_DENSE), f32) * D_MODEL ** -0.5,
        "dense_w_up": nrm(ks[10], (n_dense, D_MODEL, D_FF_DENSE), f32) * D_MODEL ** -0.5,
        "dense_w_down": nrm(ks[11], (n_dense, D_FF_DENSE, D_MODEL), f32) * D_FF_DENSE ** -0.5,
        "router": nrm(ks[12], (n_moe, D_MODEL, N_EXPERTS), f32) * D_MODEL ** -0.5,
        "exp_w_gate": nrm(ks[13], (n_moe, N_EXPERTS, D_MODEL, D_FF_EXPERT), f32) * D_MODEL ** -0.5,
        "exp_w_up": nrm(ks[14], (n_moe, N_EXPERTS, D_MODEL, D_FF_EXPERT), f32) * D_MODEL ** -0.5,
        "exp_w_down": nrm(ks[15], (n_moe, N_EXPERTS, D_FF_EXPERT, D_MODEL), f32) * D_FF_EXPERT ** -0.5,
        "final_norm": 1.0 + 0.02 * nrm(ks[16], (D_MODEL,), f32),
    }


def reference(x, mix_norm, w_in, w_gate_lr, b_gate_lr, conv_w, gla_norm, w_out, ffn_norm,
              dense_w_gate, dense_w_up, dense_w_down, router, exp_w_gate, exp_w_up, exp_w_down,
              final_norm):
    cos, sin = rope_tables(x.shape[1], HEAD_DIM)
    h = x
    for i in range(DEPTH):
        hn = rmsnorm(h, mix_norm[i])
        h = h + hybrid_mixer(hn, w_in[i], w_gate_lr[i], b_gate_lr[i], conv_w[i], gla_norm[i],
                             w_out[i], cos, sin)
        hn = rmsnorm(h, ffn_norm[i])
        j = i // 2
        if i % 2 == 0:
            h = h + swiglu(hn, dense_w_gate[j], dense_w_up[j], dense_w_down[j])
        else:
            h = h + moe_swiglu(hn, router[j], exp_w_gate[j], exp_w_up[j], exp_w_down[j])
    return rmsnorm(h, final_norm)
```

```cpp
#include <hip/hip_runtime.h>
#include <cstdio>
#include <cstdint>
#include <cmath>
namespace pg8 {
#define PG8_LAS __attribute__((address_space(3)))
typedef unsigned short bf16_t;
typedef short bf16x8 __attribute__((ext_vector_type(8)));
typedef float f32x4 __attribute__((ext_vector_type(4)));
typedef unsigned u32x4 __attribute__((ext_vector_type(4)));
constexpr int BM = 256, BK = 64, HALF = 128, HTB = HALF * BK * 2  , STAGE_BYTES = 8 * HTB, NXCD = 8, WGM = 8;

__host__ __device__ __forceinline__ int lds_byte(int r, int c) { const int st = (r >> 4) * 2 + (c >> 5), rr = r & 15, cc = c & 31, ob = rr * 64 + cc * 2; return st * 1024 + (ob ^ (((ob >> 9) & 1) << 5)); }
__host__ __device__ __forceinline__ void stage_rc(int b, int& R, int& C) { const int st = b / 1024, sb = b % 1024, swz = sb ^ (((sb >> 9) & 1) << 5); R = (st >> 1) * 16 + swz / 64; C = (st & 1) * 32 + (swz % 64) / 2; }
__host__ __device__ __forceinline__ int perm32(int rho) { const int n = rho >> 4, i = rho & 15; return 8 * (i >> 2) + 4 * n + (i & 3); }

struct Unit { int pm, pn; };
struct Gemm { const bf16_t* A; const bf16_t* Bt; int M, N, K; };

struct StaticOrder {
    int nM, nN, nwg, G, c;
    __host__ __device__ void init(int M, int N, int G_, int c_) { nM = M / BM; nN = N / BM; nwg = nM * nN; G = G_; c = c_; }
    __host__ __device__ bool next(int i, Unit& u) const {
        const long L = (long)i * G + c; if (L >= nwg) return false;
        int wgid = (int)L; { const int q = nwg / NXCD, r = nwg % NXCD, xcd = wgid % NXCD, off = wgid / NXCD; wgid = (xcd < r ? xcd * (q + 1) : r * (q + 1) + (xcd - r) * q) + off; }
        const int nig = WGM * nN, gid = wgid / nig, fm = gid * WGM, gsz = (nM - fm) < WGM ? (nM - fm) : WGM;
        u.pm = fm + ((wgid % nig) % gsz); u.pn = (wgid % nig) / gsz; return true;
    }
    __device__ __forceinline__ void a_ready(const Unit&) const {}
    __device__ __forceinline__ void done(const Unit&) const {}
};

__device__ __forceinline__ unsigned cvt_pk_bf16(float lo, float hi) { unsigned r; asm volatile("v_cvt_pk_bf16_f32 %0, %1, %2" : "=v"(r) : "v"(lo), "v"(hi)); return r; }
template <class Epi, class Sched, bool ALIGN_EPI = false, bool SP2 = false>
__device__ __forceinline__ void gemm_phase(PG8_LAS unsigned char* lds, const Gemm g, const Sched& S, const Epi& E) {
    const int tid = threadIdx.x, wid = __builtin_amdgcn_readfirstlane(tid >> 6), lane = tid & 63, wr = wid >> 2, wc = wid & 3, fr = lane & 15, fq = lane >> 4;
    const int K = g.K, nt = K / BK;
    unsigned voffA[2], voffB[2];
#pragma unroll
    for (int i = 0; i < 2; ++i) { int R, C; stage_rc(tid * 16 + i * 8192, R, C); const int Rb = Epi::PERM ? ((R & ~31) + perm32(R & 31)) : R;
        voffA[i] = (unsigned)(R * K + C) * 2u; voffB[i] = (unsigned)(Rb * K + C) * 2u; }
    const size_t kstep = (size_t)(BK * 2);
    const size_t hstep = (size_t)HALF * K * 2;
    const size_t tstep = 2 * hstep;
    const unsigned ldsw = (unsigned)wid * 1024u;
    const int aoff = lds_byte(wr * 64 + fr, fq * 8), boff = lds_byte(wc * 32 + fr, fq * 8);
#define PG8_SA(b, h) (((b) * 2 + (h)) * HTB)
#define PG8_SB(b, h) ((4 + (b) * 2 + (h)) * HTB)
#define PG8_STAGE(bufoff, gbase, voff) do { _Pragma("unroll") for (int _i = 0; _i < 2; ++_i) \
        __builtin_amdgcn_global_load_lds((const unsigned*)((const char*)(gbase) + (voff)[_i]), (PG8_LAS unsigned*)(lds + (bufoff) + ldsw + _i * 8192), 16, 0, 0); } while (0)
#define PG8_LDA(dst, b, h) do { _Pragma("unroll") for (int m = 0; m < 4; ++m) _Pragma("unroll") for (int k = 0; k < 2; ++k) dst[m][k] = *(const PG8_LAS bf16x8*)(lds + PG8_SA(b, h) + aoff + m * 2048 + k * 1024); } while (0)
#define PG8_LDB(dst, b, h) do { _Pragma("unroll") for (int n = 0; n < 2; ++n) _Pragma("unroll") for (int k = 0; k < 2; ++k) dst[n][k] = *(const PG8_LAS bf16x8*)(lds + PG8_SB(b, h) + boff + n * 2048 + k * 1024); } while (0)
#define PG8_MMA(ai, bj, At, Bt) do { __builtin_amdgcn_s_setprio(1); _Pragma("unroll") for (int m = 0; m < 4; ++m) _Pragma("unroll") for (int n = 0; n < 2; ++n) _Pragma("unroll") for (int k = 0; k < 2; ++k) \
        acc[ai][bj][m][n] = __builtin_amdgcn_mfma_f32_16x16x32_bf16(Bt[n][k], At[m][k], acc[ai][bj][m][n], 0, 0, 0); __builtin_amdgcn_s_setprio(0); } while (0)
#define PG8_WAIT_V(n) asm volatile("s_waitcnt vmcnt(" #n ")" ::: "memory")
#define PG8_WAIT_L(n) asm volatile("s_waitcnt lgkmcnt(" #n ")" ::: "memory")
#define PG8_BAR __builtin_amdgcn_s_barrier()
#define PG8_SCHED __builtin_amdgcn_sched_barrier(0)
    Unit cur, nxt; int ui = 0;
    if (!S.next(0, cur)) return;
    f32x4 acc[2][2][4][2];
#pragma unroll
    for (int a = 0; a < 2; ++a)
#pragma unroll
        for (int b = 0; b < 2; ++b)
#pragma unroll
            for (int m = 0; m < 4; ++m)
#pragma unroll
                for (int n = 0; n < 2; ++n) acc[a][b][m][n] = (f32x4){0.f, 0.f, 0.f, 0.f};
    bf16x8 At[4][2], B0[2][2], B1[2][2];
    const char* cA = (const char*)g.A + (size_t)cur.pm * tstep; const char* cB = (const char*)g.Bt + (size_t)cur.pn * tstep;
    S.a_ready(cur);
    if constexpr (SP2) {
        PG8_STAGE(PG8_SB(0, 0), cB, voffB); PG8_STAGE(PG8_SB(0, 1), cB + hstep, voffB); PG8_STAGE(PG8_SA(0, 0), cA, voffA); PG8_STAGE(PG8_SA(0, 1), cA + hstep, voffA);
        if (wr == 1) PG8_BAR;
        PG8_WAIT_V(2); PG8_BAR;
        PG8_STAGE(PG8_SB(1, 0), cB + kstep, voffB); PG8_STAGE(PG8_SA(1, 0), cA + kstep, voffA); PG8_STAGE(PG8_SB(1, 1), cB + hstep + kstep, voffB);
        PG8_WAIT_V(6); PG8_BAR;
    } else {
        PG8_STAGE(PG8_SB(0, 0), cB, voffB); PG8_STAGE(PG8_SA(0, 0), cA, voffA); PG8_STAGE(PG8_SB(0, 1), cB + hstep, voffB); PG8_STAGE(PG8_SA(0, 1), cA + hstep, voffA);
        if (wr == 1) PG8_BAR;
        PG8_WAIT_V(4); PG8_BAR;
        PG8_STAGE(PG8_SB(1, 0), cB + kstep, voffB); PG8_STAGE(PG8_SA(1, 0), cA + kstep, voffA); PG8_STAGE(PG8_SB(1, 1), cB + hstep + kstep, voffB);
        PG8_WAIT_V(6); PG8_BAR;
    }
    for (;;) {
        const bool has_next = S.next(ui + 1, nxt);
        const char* nA = has_next ? (const char*)g.A + (size_t)nxt.pm * tstep : cA; const char* nB = has_next ? (const char*)g.Bt + (size_t)nxt.pn * tstep : cB;
        for (int t = 0; t < nt; t += 2) {
            const bool last = (t == nt - 2);
            const char* a1 = cA + (size_t)(t + 1) * kstep;
            const char* a2 = last ? nA : cA + (size_t)(t + 2) * kstep; const char* b2 = last ? nB : cB + (size_t)(t + 2) * kstep;
            const char* a3 = a2 + kstep; const char* b3 = b2 + kstep;
            if (last && has_next) S.a_ready(nxt);
            if constexpr (SP2) {
            PG8_LDB(B0, 0, 0); PG8_LDB(B1, 0, 1); PG8_SCHED; PG8_LDA(At, 0, 0); PG8_STAGE(PG8_SA(1, 1), a1 + hstep, voffA);
            PG8_WAIT_V(8); PG8_WAIT_L(0); PG8_BAR; PG8_MMA(0, 0, At, B0); PG8_MMA(0, 1, At, B1); PG8_BAR; PG8_SCHED;
            PG8_LDA(At, 0, 1); PG8_STAGE(PG8_SB(0, 0), b2, voffB); PG8_STAGE(PG8_SB(0, 1), b2 + hstep, voffB); PG8_STAGE(PG8_SA(0, 0), a2, voffA);
            PG8_WAIT_V(8); PG8_WAIT_L(0); PG8_BAR; PG8_MMA(1, 0, At, B0); PG8_MMA(1, 1, At, B1); PG8_BAR; PG8_SCHED;
            PG8_LDB(B0, 1, 0); PG8_LDB(B1, 1, 1); PG8_SCHED; PG8_LDA(At, 1, 0); PG8_STAGE(PG8_SA(0, 1), a2 + hstep, voffA);
            PG8_WAIT_V(8); PG8_WAIT_L(0); PG8_BAR; PG8_MMA(0, 0, At, B0); PG8_MMA(0, 1, At, B1); PG8_BAR; PG8_SCHED;
            PG8_LDA(At, 1, 1); PG8_STAGE(PG8_SB(1, 0), b3, voffB); PG8_STAGE(PG8_SB(1, 1), b3 + hstep, voffB); PG8_STAGE(PG8_SA(1, 0), a3, voffA);
            PG8_WAIT_V(8); PG8_WAIT_L(0); PG8_BAR; PG8_MMA(1, 0, At, B0); PG8_MMA(1, 1, At, B1); PG8_BAR; PG8_SCHED;
            } else {
            PG8_LDB(B0, 0, 0); PG8_SCHED; PG8_LDA(At, 0, 0); PG8_STAGE(PG8_SA(1, 1), a1 + hstep, voffA);
            PG8_WAIT_L(8); PG8_BAR; PG8_WAIT_L(0); PG8_MMA(0, 0, At, B0); PG8_BAR; PG8_SCHED;
            PG8_LDB(B1, 0, 1); PG8_STAGE(PG8_SB(0, 0), b2, voffB);
            PG8_BAR; PG8_WAIT_L(0); PG8_MMA(0, 1, At, B1); PG8_BAR;
            PG8_LDA(At, 0, 1); PG8_STAGE(PG8_SA(0, 0), a2, voffA);
            PG8_BAR; PG8_WAIT_L(0); PG8_MMA(1, 0, At, B0); PG8_BAR; PG8_SCHED;
            PG8_STAGE(PG8_SB(0, 1), b2 + hstep, voffB);
            PG8_WAIT_V(6); PG8_BAR; PG8_MMA(1, 1, At, B1); PG8_BAR;
            PG8_LDB(B0, 1, 0); PG8_SCHED; PG8_LDA(At, 1, 0); PG8_STAGE(PG8_SA(0, 1), a2 + hstep, voffA);
            PG8_WAIT_L(8); PG8_BAR; PG8_WAIT_L(0); PG8_MMA(0, 0, At, B0); PG8_BAR; PG8_SCHED;
            PG8_LDB(B1, 1, 1); PG8_STAGE(PG8_SB(1, 0), b3, voffB);
            PG8_BAR; PG8_WAIT_L(0); PG8_MMA(0, 1, At, B1); PG8_BAR;
            PG8_LDA(At, 1, 1); PG8_STAGE(PG8_SA(1, 0), a3, voffA);
            PG8_BAR; PG8_WAIT_L(0); PG8_MMA(1, 0, At, B0); PG8_BAR; PG8_SCHED;
            PG8_STAGE(PG8_SB(1, 1), b3 + hstep, voffB);
            PG8_WAIT_V(6); PG8_BAR; PG8_MMA(1, 1, At, B1); PG8_BAR;
            }
        }
        if constexpr (ALIGN_EPI) { if (wr == 0) PG8_BAR; }
        if constexpr (!Epi::AFTER_DRAIN) { E(acc, cur, wr, wc, fr, fq); S.done(cur); }
        if (!has_next) break;
#pragma unroll
        for (int a = 0; a < 2; ++a)
#pragma unroll
            for (int b = 0; b < 2; ++b)
#pragma unroll
                for (int m = 0; m < 4; ++m)
#pragma unroll
                    for (int n = 0; n < 2; ++n) acc[a][b][m][n] = (f32x4){0.f, 0.f, 0.f, 0.f};
        cur = nxt; cA = nA; cB = nB; ++ui;
        if constexpr (ALIGN_EPI) { if (wr == 1) PG8_BAR; }
    }
    PG8_WAIT_V(0);
    if constexpr (!ALIGN_EPI) { if (wr == 0) PG8_BAR; }
    PG8_BAR;
    if constexpr (Epi::AFTER_DRAIN) { E.fused(acc, cur, wr, wc, fr, fq, lds, wid, lane); S.done(cur); }
#undef PG8_SA
#undef PG8_SB
#undef PG8_STAGE
#undef PG8_LDA
#undef PG8_LDB
#undef PG8_MMA
#undef PG8_WAIT_V
#undef PG8_WAIT_L
#undef PG8_BAR
#undef PG8_SCHED
}
}
#define GAS __attribute__((address_space(1)))
#define LAS __attribute__((address_space(3)))
typedef unsigned short bf16;
typedef unsigned v4u __attribute__((ext_vector_type(4)));
typedef float f32x4 __attribute__((ext_vector_type(4)));
typedef short bf16x8 __attribute__((ext_vector_type(8)));
typedef GAS unsigned gu32;
typedef GAS unsigned long long gu64;
#define RLX_AGENT __ATOMIC_RELAXED, __HIP_MEMORY_SCOPE_AGENT
#define LDS_WAIT() asm volatile("s_waitcnt lgkmcnt(0)" ::: "memory")
#define VM_WAIT() asm volatile("s_waitcnt vmcnt(0)" ::: "memory")
__device__ __forceinline__ unsigned long long rt() { return __builtin_amdgcn_s_memrealtime(); }
__device__ __forceinline__ unsigned f2bf(float f) { unsigned u = __builtin_bit_cast(unsigned, f); return (u + 0x7fffu + ((u >> 16) & 1u)) >> 16; }
__device__ __forceinline__ unsigned pk2(float lo, float hi) { return f2bf(lo) | (f2bf(hi) << 16); }

#define XB_TMO      128
#define XB_XCNT(j)  (256  + 64 * (j))
#define XB_XSUB(j)  (1280 + 64 * (j))
#define XB_XGEN(j)  (2304 + 64 * (j))
#define XB_TOP      3328
#define XB_TOPGEN   3392
#define XCD_BAR_WORDS 3456
#define XB_SPIN_CAP (1u << 18)

__device__ __forceinline__ unsigned xb_ld(unsigned* p)              { return __hip_atomic_load(p, __ATOMIC_RELAXED, __HIP_MEMORY_SCOPE_AGENT); }
__device__ __forceinline__ unsigned xb_add(unsigned* p, unsigned v) { return __hip_atomic_fetch_add(p, v, __ATOMIC_RELAXED, __HIP_MEMORY_SCOPE_AGENT); }
__device__ __forceinline__ unsigned xb_xcc_id() { return (unsigned)__builtin_amdgcn_s_getreg((3 << 11) | 20) & 0xFu; }
#define XB_SPIN(cond, bar) do { unsigned _sp = 0; while (cond) { __builtin_amdgcn_s_sleep(1); \
    if ((++_sp & 255u) == 0u) { if (xb_ld(&(bar)[XB_TMO])) break; if (_sp > XB_SPIN_CAP) { atomicAdd(&(bar)[XB_TMO], 1u); break; } } } } while (0)

struct XcdBarrier {
    unsigned* bar; unsigned x;
    volatile LAS unsigned* st;
};

__device__ __forceinline__ XcdBarrier xcd_barrier_post(unsigned* bar, volatile LAS unsigned* st) {
    XcdBarrier b; b.bar = bar; b.x = xb_xcc_id(); b.st = st;
    if (threadIdx.x == 0) (void)xb_add(&bar[XB_XCNT(b.x)], 1u);
    return b;
}
__device__ __forceinline__ void xcd_barrier_complete(unsigned* bar, unsigned x, unsigned& nloc, unsigned& nx) {
    const unsigned G = gridDim.x * gridDim.y * gridDim.z;
    unsigned sum, cnt, mine, sp = 0u;
    for (;;) {
        sum = 0u; cnt = 0u; mine = 0u;
#pragma unroll
        for (unsigned j = 0; j < 16; ++j) { const unsigned c = xb_ld(&bar[XB_XCNT(j)]); sum += c; cnt += (c > 0u) ? 1u : 0u; mine = (j == x) ? c : mine; }
        if (sum == G) break;
        __builtin_amdgcn_s_sleep(1);
        if ((++sp & 255u) == 0u) { if (xb_ld(&bar[XB_TMO])) break; if (sp > XB_SPIN_CAP) { atomicAdd(&bar[XB_TMO], 1u); break; } }
    }
    nloc = mine > 0u ? mine : 1u; nx = cnt > 0u ? cnt : 1u;
}

__device__ __forceinline__ void xcd_barrier(const XcdBarrier& b) {
    asm volatile("s_waitcnt vmcnt(0)" ::: "memory");
    __syncthreads();
    if (threadIdx.x == 0) {
        unsigned* bar = b.bar;
        __builtin_amdgcn_s_waitcnt(0);
        unsigned nloc = b.st[0], nx = b.st[1];
        if (nloc == 0u) { xcd_barrier_complete(bar, b.x, nloc, nx); b.st[0] = nloc; b.st[1] = nx; }
        const unsigned old = xb_add(&bar[XB_XSUB(b.x)], 1u);
        const unsigned gen = old / nloc;
        if (old + 1u == (gen + 1u) * nloc) {
            __builtin_amdgcn_fence(__ATOMIC_RELEASE, "agent");
            asm volatile("s_waitcnt vmcnt(0)" ::: "memory");
            const unsigned og = xb_add(&bar[XB_TOP], 1u);
            const unsigned tg = og / nx;
            if (og + 1u == (tg + 1u) * nx) xb_add(&bar[XB_TOPGEN], 1u);
            else XB_SPIN(xb_ld(&bar[XB_TOPGEN]) == tg, bar);
            __builtin_amdgcn_fence(__ATOMIC_ACQUIRE, "agent");
            xb_add(&bar[XB_XGEN(b.x)], 1u);
            asm volatile("s_waitcnt vmcnt(0)" ::: "memory");
        } else {
            XB_SPIN(xb_ld(&bar[XB_XGEN(b.x)]) == gen, bar);
            __builtin_amdgcn_fence(__ATOMIC_ACQUIRE, "agent");
            asm volatile("s_waitcnt vmcnt(0)" ::: "memory");
        }
    }
    __syncthreads();
}

constexpr int NB = 2, SEQ = 8192, T = NB * SEQ, DM = 1024;
constexpr int NPROJ = 3072, INTOT = 3088;
constexpr int FFD = 2816, FFE = 3584, NEXP = 8;
constexpr float EPS = 1e-6f;
constexpr float LOG2E = 1.4426950408889634f;
constexpr float C2Q = 0.125f * LOG2E;
constexpr int PC_Q = 0, PC_K = 512, PC_V = 1024, PC_CB = 1536, PC_CC = 1792, PC_CH = 2048, PC_GQ = 2304, PC_GK = 2432, PC_GV = 2560, PC_GO = 2816;
constexpr int NWAVES = 8;
constexpr int MOE_PB = 68;
constexpr int MOE_MAXSLOT = 34816;

constexpr size_t MiB = 1u << 20;
constexpr size_t WS_CTL = 0, CTL_ZERO_BYTES = 1 * MiB;
constexpr size_t WS_ROPE = 1 * MiB;
constexpr size_t WS_RG = 3 * MiB;
constexpr size_t WS_WGZ = 3 * MiB + 64 * 1024;
constexpr size_t WS_BLKCNT = 3 * MiB + 128 * 1024;
constexpr size_t WS_PANEL = 3 * MiB + 192 * 1024;
constexpr size_t WS_TOKE = 4 * MiB;
constexpr size_t WS_TOKW = 4 * MiB + 128 * 1024;
constexpr size_t WS_TOKS = 4 * MiB + 256 * 1024;
constexpr size_t WS_SRSTD = 4 * MiB + 384 * 1024;
constexpr size_t WS_GZ = 5 * MiB;
constexpr size_t WS_WIN = 6 * MiB;
constexpr size_t WS_WOUT = 18 * MiB;
constexpr size_t WS_WGU = 22 * MiB;
constexpr size_t WS_WD = 33 * MiB;
constexpr size_t WS_EGU = 39 * MiB;
constexpr size_t WS_ED = 151 * MiB;
constexpr size_t WS_HB = 207 * MiB;
constexpr size_t WS_SSP = 239 * MiB;
constexpr size_t WS_DYN = 244 * MiB;
constexpr size_t WS_PROJ = WS_DYN;
constexpr size_t WS_MIX = WS_DYN + 96 * MiB;
constexpr size_t WS_ACT = WS_DYN;
constexpr size_t WS_ASORT = WS_DYN;
constexpr size_t WS_EACT = WS_DYN + 68 * MiB;
constexpr size_t WS_END = WS_DYN + 187 * MiB;
constexpr int CW_TMO = 0, CW_BAR = 4096;

constexpr int RING_OFF = 0, RING_BYTES = 131072;
constexpr int LDSCTL_OFF = RING_BYTES, MISC_OFF = LDSCTL_OFF + 320;
constexpr int LDS_BYTES = 147456;

__device__ __forceinline__ float bf2f(unsigned short b) { return __uint_as_float(((unsigned)b) << 16); }
__device__ __forceinline__ float bflo(unsigned w) { return __uint_as_float(w << 16); }
__device__ __forceinline__ float bfhi(unsigned w) { return __uint_as_float(w & 0xffff0000u); }
__device__ __forceinline__ float wave_sum(float v) {
#pragma unroll
    for (int o = 1; o < 64; o <<= 1) v += __shfl_xor(v, o);
    return v;
}
__device__ __forceinline__ float fast_exp2(float x) { return __builtin_amdgcn_exp2f(x); }
__device__ __forceinline__ float fast_rcp(float x) { return __builtin_amdgcn_rcpf(x); }
__device__ __forceinline__ float sigmoidf_(float x) { return fast_rcp(1.0f + fast_exp2(-x * LOG2E)); }

__device__ __forceinline__ float row_rstd(const float* ssp, int row) {
    const float4 a = *(const float4*)(ssp + (size_t)row * 16), b = *(const float4*)(ssp + (size_t)row * 16 + 4), c = *(const float4*)(ssp + (size_t)row * 16 + 8), d = *(const float4*)(ssp + (size_t)row * 16 + 12);
    const float s = ((a.x + a.y) + (a.z + a.w)) + ((b.x + b.y) + (b.z + b.w)) + ((c.x + c.y) + (c.z + c.w)) + ((d.x + d.y) + (d.z + d.w));
    return 1.0f / sqrtf(s * (1.0f / DM) + EPS);
}

namespace pg8 {
struct EpiProj {
    static constexpr bool PERM = true, AFTER_DRAIN = false;
    bf16_t* O; const float* ss; const float* rope;
    __device__ __forceinline__ void operator()(const f32x4 (&acc)[2][2][4][2], const Unit& u, int wr, int wc, int fr, int fq) const {
        const int row0 = u.pm * BM + wr * 64 + fr, colb = u.pn * BM + wc * 32 + 8 * fq;
        const bool isrope = u.pn < 4; const float qs = (u.pn < 2) ? C2Q : 1.0f;
        const int i0 = 16 * (wc & 1) + 4 * fq;
#pragma unroll
        for (int ai = 0; ai < 2; ++ai)
#pragma unroll
            for (int m = 0; m < 4; ++m) {
                const int row = row0 + ai * HALF + m * 16;
                const float rstd = row_rstd(ss, row);
                f32x4 cs0 = (f32x4){1.f, 0.f, 1.f, 0.f}, cs1 = cs0;
                if (isrope) { const float* rp = rope + ((size_t)(row & (SEQ - 1)) * 32 + i0) * 2; cs0 = *(const f32x4*)rp; cs1 = *(const f32x4*)(rp + 4); }
                bf16_t* rowp = O + (size_t)row * NPROJ + colb;
#pragma unroll
                for (int bj = 0; bj < 2; ++bj) {
                    f32x4 v0 = acc[ai][bj][m][0] * rstd, v1 = acc[ai][bj][m][1] * rstd;
                    if (isrope) {
                        f32x4 w0, w1;
                        w0[0] = v0[0] * cs0[0] - v0[1] * cs0[1]; w0[1] = v0[0] * cs0[1] + v0[1] * cs0[0];
                        w0[2] = v0[2] * cs0[2] - v0[3] * cs0[3]; w0[3] = v0[2] * cs0[3] + v0[3] * cs0[2];
                        w1[0] = v1[0] * cs1[0] - v1[1] * cs1[1]; w1[1] = v1[0] * cs1[1] + v1[1] * cs1[0];
                        w1[2] = v1[2] * cs1[2] - v1[3] * cs1[3]; w1[3] = v1[2] * cs1[3] + v1[3] * cs1[2];
                        v0 = w0 * qs; v1 = w1 * qs;
                    }
                    u32x4 w; w.x = cvt_pk_bf16(v0[0], v0[1]); w.y = cvt_pk_bf16(v0[2], v0[3]); w.z = cvt_pk_bf16(v1[0], v1[1]); w.w = cvt_pk_bf16(v1[2], v1[3]);
                    *(u32x4*)(rowp + bj * HALF) = w;
                }
            }
    }
};
struct EpiResid {
    static constexpr bool PERM = true, AFTER_DRAIN = false;
    const float* base; float* out; bf16_t* hb; float* ssout;
    __device__ __forceinline__ void operator()(const f32x4 (&acc)[2][2][4][2], const Unit& u, int wr, int wc, int fr, int fq) const {
        const int row0 = u.pm * BM + wr * 64 + fr, colb = u.pn * BM + wc * 32 + 8 * fq;
#pragma unroll
        for (int ai = 0; ai < 2; ++ai)
#pragma unroll
            for (int m = 0; m < 4; ++m) {
                const int row = row0 + ai * HALF + m * 16; const size_t off = (size_t)row * DM + colb; float sq = 0.f;
#pragma unroll
                for (int bj = 0; bj < 2; ++bj) {
                    const f32x4 b0 = *(const f32x4*)(base + off + bj * HALF), b1 = *(const f32x4*)(base + off + bj * HALF + 4);
                    const f32x4 v0 = acc[ai][bj][m][0] + b0, v1 = acc[ai][bj][m][1] + b1;
                    *(f32x4*)(out + off + bj * HALF) = v0; *(f32x4*)(out + off + bj * HALF + 4) = v1;
                    u32x4 w; w.x = cvt_pk_bf16(v0[0], v0[1]); w.y = cvt_pk_bf16(v0[2], v0[3]); w.z = cvt_pk_bf16(v1[0], v1[1]); w.w = cvt_pk_bf16(v1[2], v1[3]);
                    *(u32x4*)(hb + off + bj * HALF) = w;
                    sq += (v0[0] * v0[0] + v0[1] * v0[1]) + (v0[2] * v0[2] + v0[3] * v0[3]) + (v1[0] * v1[0] + v1[1] * v1[1]) + (v1[2] * v1[2] + v1[3] * v1[3]);
                }
                sq += __shfl_xor(sq, 16); sq += __shfl_xor(sq, 32);
                if (fq == 0) ssout[(size_t)row * 16 + u.pn * 4 + wc] = sq;
            }
    }
};
struct EpiSwiglu {
    static constexpr bool PERM = true, AFTER_DRAIN = false;
    bf16_t* O; int ldo; const float* ss; const float* rstdv; int row_off; int ntile;
    __device__ __forceinline__ void operator()(const f32x4 (&acc)[2][2][4][2], const Unit& u, int wr, int wc, int fr, int fq) const {
        const int row0 = u.pm * BM + wr * 64 + fr, col = (u.pn % ntile) * HALF + wc * 32 + 8 * fq;
#pragma unroll
        for (int ai = 0; ai < 2; ++ai)
#pragma unroll
            for (int m = 0; m < 4; ++m) {
                const int row = row0 + ai * HALF + m * 16;
                const float rstd = rstdv ? rstdv[row] : row_rstd(ss, row);
                float a[8];
#pragma unroll
                for (int n = 0; n < 2; ++n)
#pragma unroll
                    for (int j = 0; j < 4; ++j) { const float g = acc[ai][0][m][n][j] * rstd, uu = acc[ai][1][m][n][j] * rstd; a[n * 4 + j] = g * sigmoidf_(g) * uu; }
                u32x4 w; w.x = cvt_pk_bf16(a[0], a[1]); w.y = cvt_pk_bf16(a[2], a[3]); w.z = cvt_pk_bf16(a[4], a[5]); w.w = cvt_pk_bf16(a[6], a[7]);
                *(u32x4*)(O + (size_t)(row - row_off) * ldo + col) = w;
            }
    }
};
struct EpiMoeDown {
    static constexpr bool PERM = true, AFTER_DRAIN = false;
    bf16_t* Y;
    __device__ __forceinline__ void operator()(const f32x4 (&acc)[2][2][4][2], const Unit& u, int wr, int wc, int fr, int fq) const {
        const int row0 = u.pm * BM + wr * 64 + fr, colb = (u.pn & 3) * BM + wc * 32 + 8 * fq;
#pragma unroll
        for (int ai = 0; ai < 2; ++ai)
#pragma unroll
            for (int m = 0; m < 4; ++m) {
                const int row = row0 + ai * HALF + m * 16;
#pragma unroll
                for (int bj = 0; bj < 2; ++bj) {
                    const f32x4 v0 = acc[ai][bj][m][0], v1 = acc[ai][bj][m][1];
                    u32x4 w; w.x = cvt_pk_bf16(v0[0], v0[1]); w.y = cvt_pk_bf16(v0[2], v0[3]); w.z = cvt_pk_bf16(v1[0], v1[1]); w.w = cvt_pk_bf16(v1[2], v1[3]);
                    *(u32x4*)(Y + (size_t)row * DM + colb + bj * HALF) = w;
                }
            }
    }
};
struct MoeOrder {
    int nM, nN, nwg, G, c, p0; const int* pexp;
    __device__ void init(int np, int nN_, int G_, int c_, int p0_, const int* pexp_) { nM = np; nN = nN_; nwg = nM * nN; G = G_; c = c_; p0 = p0_; pexp = pexp_; }
    __device__ bool next(int i, Unit& u) const {
        const long L = (long)i * G + c; if (L >= nwg) return false;
        int wgid = (int)L; { const int q = nwg / NXCD, r = nwg % NXCD, xcd = wgid % NXCD, off = wgid / NXCD; wgid = (xcd < r ? xcd * (q + 1) : r * (q + 1) + (xcd - r) * q) + off; }
        const int nig = WGM * nN, gid = wgid / nig, fm = gid * WGM, gsz = (nM - fm) < WGM ? (nM - fm) : WGM;
        const int pm = p0 + fm + ((wgid % nig) % gsz), pn = (wgid % nig) / gsz;
        u.pm = pm; u.pn = pexp[pm] * nN + pn; return true;
    }
    __device__ __forceinline__ void a_ready(const Unit&) const {}
    __device__ __forceinline__ void done(const Unit&) const {}
};
}

struct Frame {
    LAS unsigned char* lds;
    volatile LAS unsigned* MISC;
    gu32* ctl;
    int tid, lane, wave;
    int vcu, G;
    unsigned char* ws;
    const float* in[17];
    float* out;
};
enum { I_X = 0, I_MIXNORM, I_WIN, I_WGLR, I_BGLR, I_CONVW, I_GLANORM, I_WOUT, I_FFNNORM, I_DWG, I_DWU, I_DWD, I_ROUTER, I_EWG, I_EWU, I_EWD, I_FINALNORM };

__device__ __forceinline__ float* ss_arr(Frame& F, int k) { return (float*)(F.ws + WS_SSP) + (size_t)k * T * 16; }

__device__ __forceinline__ int dst_row(int mode, int n) {
    if (mode == 1) { if (n < 1024) { const int d = n & 63; return (n & ~63) + ((d < 32) ? 2 * d : 2 * (d - 32) + 1); } return n; }
    if (mode == 2) return (n >> 7) * 256 + (n & 127);
    if (mode == 3) return (n >> 7) * 256 + 128 + (n & 127);
    return n;
}
__device__ __forceinline__ void transpose_item(const float* W, int K, int N, int nblk, const float* gain, bf16* WT, int mode, LAS float* scr, int item, int lane) {
    const int kb = item / nblk, nb = item % nblk, k0 = 64 * kb, n0 = 32 * nb;
#pragma unroll 8
    for (int i = 0; i < 32; ++i) { const int kk = 2 * i + (lane >> 5); float v = W[(size_t)(k0 + kk) * N + n0 + (lane & 31)]; if (gain) v *= gain[k0 + kk]; scr[kk * 33 + (lane & 31)] = v; }
    LDS_WAIT(); asm volatile("" ::: "memory");
    const int c = lane & 7;
#pragma unroll
    for (int j = 0; j < 4; ++j) { const int n = (lane >> 3) + 8 * j; const LAS float* s = scr + (8 * c) * 33 + n;
        v4u o; o.x = pk2(s[0 * 33], s[1 * 33]); o.y = pk2(s[2 * 33], s[3 * 33]); o.z = pk2(s[4 * 33], s[5 * 33]); o.w = pk2(s[6 * 33], s[7 * 33]);
        *(GAS v4u*)(WT + (size_t)dst_row(mode, n0 + n) * K + k0 + 8 * c) = o; }
    LDS_WAIT(); asm volatile("" ::: "memory");
}
__device__ __forceinline__ void p0_prologue(Frame& F) {
    LAS float* scr = (LAS float*)(F.lds + RING_OFF + F.wave * 16384);
    const int gw = F.vcu * NWAVES + F.wave, NGW = F.G * NWAVES, lane = F.lane;
    constexpr int I_IN = 16 * 96, I_OUT = 16 * 32, I_DG = 16 * 88, I_DD = 44 * 32, I_EG = 16 * 112, I_EDN = 56 * 32;
    constexpr int NITEMS = 2 * I_IN + 2 * I_OUT + 2 * I_DG + I_DD + NEXP * (2 * I_EG + I_EDN);
    for (int it = gw; it < NITEMS; it += NGW) {
        int r = it;
        if (r < 2 * I_IN) { const int l = r / I_IN; r -= l * I_IN;
            transpose_item(F.in[I_WIN] + (size_t)l * DM * INTOT, DM, INTOT, 96, F.in[I_MIXNORM] + l * DM, (bf16*)(F.ws + WS_WIN) + (size_t)l * NPROJ * DM, 1, scr, r, lane); continue; } r -= 2 * I_IN;
        if (r < 2 * I_OUT) { const int l = r / I_OUT; r -= l * I_OUT;
            transpose_item(F.in[I_WOUT] + (size_t)l * DM * DM, DM, DM, 32, nullptr, (bf16*)(F.ws + WS_WOUT) + (size_t)l * DM * DM, 0, scr, r, lane); continue; } r -= 2 * I_OUT;
        if (r < I_DG) { transpose_item(F.in[I_DWG], DM, FFD, 88, F.in[I_FFNNORM], (bf16*)(F.ws + WS_WGU), 2, scr, r, lane); continue; } r -= I_DG;
        if (r < I_DG) { transpose_item(F.in[I_DWU], DM, FFD, 88, F.in[I_FFNNORM], (bf16*)(F.ws + WS_WGU), 3, scr, r, lane); continue; } r -= I_DG;
        if (r < I_DD) { transpose_item(F.in[I_DWD], FFD, DM, 32, nullptr, (bf16*)(F.ws + WS_WD), 0, scr, r, lane); continue; } r -= I_DD;
        { const int e = r / (2 * I_EG + I_EDN); r -= e * (2 * I_EG + I_EDN);
          if (r < I_EG) { transpose_item(F.in[I_EWG] + (size_t)e * DM * FFE, DM, FFE, 112, F.in[I_FFNNORM] + DM, (bf16*)(F.ws + WS_EGU) + (size_t)e * 2 * FFE * DM, 2, scr, r, lane); continue; } r -= I_EG;
          if (r < I_EG) { transpose_item(F.in[I_EWU] + (size_t)e * DM * FFE, DM, FFE, 112, F.in[I_FFNNORM] + DM, (bf16*)(F.ws + WS_EGU) + (size_t)e * 2 * FFE * DM, 3, scr, r, lane); continue; } r -= I_EG;
          transpose_item(F.in[I_EWD] + (size_t)e * FFE * DM, FFE, DM, 32, nullptr, (bf16*)(F.ws + WS_ED) + (size_t)e * DM * FFE, 0, scr, r, lane); }
    }
    {
        float* ss0 = ss_arr(F, 0); bf16* HB = (bf16*)(F.ws + WS_HB);
        for (int m = gw; m < T; m += NGW) {
            const GAS f32x4* xr = (const GAS f32x4*)(F.in[I_X] + (size_t)m * DM) + lane;
            f32x4 v[4]; float s = 0.f;
#pragma unroll
            for (int j = 0; j < 4; ++j) { v[j] = xr[64 * j]; s += (v[j].x * v[j].x + v[j].y * v[j].y) + (v[j].z * v[j].z + v[j].w * v[j].w); }
            s = wave_sum(s);
            GAS unsigned long long* o8 = (GAS unsigned long long*)(HB + (size_t)m * DM) + lane;
#pragma unroll
            for (int j = 0; j < 4; ++j) o8[64 * j] = (unsigned long long)pk2(v[j].x, v[j].y) | ((unsigned long long)pk2(v[j].z, v[j].w) << 32);
            if (lane < 16) ss0[(size_t)m * 16 + lane] = (lane == 0) ? s : 0.f;
        }
    }
    const int gt = F.vcu * (NWAVES * 64) + F.tid, NGT = F.G * NWAVES * 64;
    for (int i = gt; i < 2 * 16 * DM; i += NGT) { const int l = i / (16 * DM), r = (i / DM) & 15, k = i & (DM - 1);
        ((bf16*)(F.ws + WS_WGZ))[i] = (bf16)f2bf(F.in[I_WIN][(size_t)l * DM * INTOT + (size_t)k * INTOT + NPROJ + r] * F.in[I_MIXNORM][l * DM + k]); }
    for (int i = gt; i < DM * NEXP; i += NGT) ((float*)(F.ws + WS_RG))[i] = F.in[I_ROUTER][i] * F.in[I_FFNNORM][DM + (i >> 3)];
    for (int i = gt; i < SEQ * 32; i += NGT) { const int pos = i >> 5, fi = i & 31;
        const float inv = 1.0f / powf(10000.0f, (float)(2 * fi) / 64.0f);
        const float ang = (float)pos * inv;
        const double rev = (double)ang * 0.15915494309189535; const double fr = rev - rint(rev);
        const float f = (float)fr;
        float* o = (float*)(F.ws + WS_ROPE) + (size_t)i * 2; o[0] = __builtin_amdgcn_cosf(f); o[1] = __builtin_amdgcn_sinf(f); }
}

__device__ __forceinline__ void gz_phase(Frame& F, const bf16* HB, const bf16* WGZ, const float* ss, float* GZ) {
    const int gw = F.vcu * NWAVES + F.wave, NGW = F.G * NWAVES, lane = F.lane;
    for (int task = gw; task < T / 16; task += NGW) {
        const int t0 = task * 16;
        const bf16* ap = WGZ + (size_t)(lane & 15) * DM + 8 * (lane >> 4);
        const bf16* bp = HB + (size_t)(t0 + (lane & 15)) * DM + 8 * (lane >> 4);
        f32x4 acc = (f32x4){0.f, 0.f, 0.f, 0.f};
#pragma unroll 8
        for (int s = 0; s < 32; ++s) { const bf16x8 a = *(const bf16x8*)(ap + 32 * s), b = *(const bf16x8*)(bp + 32 * s);
            acc = __builtin_amdgcn_mfma_f32_16x16x32_bf16(a, b, acc, 0, 0, 0); }
        const int tok = t0 + (lane & 15);
        const float rstd = row_rstd(ss, tok);
        *(f32x4*)(GZ + (size_t)tok * 16 + 4 * (lane >> 4)) = acc * rstd;
    }
}

__device__ __forceinline__ void attn_naive_task(const bf16* PROJ, bf16* MIX, int task, int lane) {
    const int blk = task & 127, h = (task >> 7) & 7, b = task >> 10;
    const int tpos = blk * 64 + lane; const size_t row = (size_t)b * SEQ + tpos;
    float q[64], o[64];
    { const v4u* qp = (const v4u*)(PROJ + row * NPROJ + PC_Q + h * 64);
#pragma unroll
      for (int c = 0; c < 8; ++c) { const v4u w = qp[c]; q[8 * c + 0] = bflo(w.x); q[8 * c + 1] = bfhi(w.x); q[8 * c + 2] = bflo(w.y); q[8 * c + 3] = bfhi(w.y); q[8 * c + 4] = bflo(w.z); q[8 * c + 5] = bfhi(w.z); q[8 * c + 6] = bflo(w.w); q[8 * c + 7] = bfhi(w.w); } }
#pragma unroll
    for (int d = 0; d < 64; ++d) o[d] = 0.f;
    float m = -1e30f, l = 0.f;
    for (int br = 0; br < 3; ++br) {
        const int dl = (br == 0) ? 1 : (br == 1) ? 4 : 16;
        for (int j = 0; j <= 128; ++j) {
            int kp = tpos - j * dl; const bool valid = (kp >= 0); if (kp < 0) kp = 0; const size_t krow = (size_t)b * SEQ + kp;
            const v4u* kptr = (const v4u*)(PROJ + krow * NPROJ + PC_K + h * 64); float acc = 0.f;
#pragma unroll
            for (int c = 0; c < 8; ++c) { const v4u w = kptr[c];
                acc += q[8 * c + 0] * bflo(w.x) + q[8 * c + 1] * bfhi(w.x) + q[8 * c + 2] * bflo(w.y) + q[8 * c + 3] * bfhi(w.y) + q[8 * c + 4] * bflo(w.z) + q[8 * c + 5] * bfhi(w.z) + q[8 * c + 6] * bflo(w.w) + q[8 * c + 7] * bfhi(w.w); }
            const float sc = valid ? acc : -1e30f;
            const float mn = fmaxf(m, sc);
            const float alpha = fast_exp2(m - mn); m = mn;
            const float p = valid ? fast_exp2(sc - mn) : 0.f; l = l * alpha + p;
            asm volatile("" ::: "memory");
            const v4u* vptr = (const v4u*)(PROJ + krow * NPROJ + PC_V + h * 64);
#pragma unroll
            for (int c = 0; c < 8; ++c) { const v4u w = vptr[c];
                o[8 * c + 0] = o[8 * c + 0] * alpha + p * bflo(w.x); o[8 * c + 1] = o[8 * c + 1] * alpha + p * bfhi(w.x); o[8 * c + 2] = o[8 * c + 2] * alpha + p * bflo(w.y); o[8 * c + 3] = o[8 * c + 3] * alpha + p * bfhi(w.y);
                o[8 * c + 4] = o[8 * c + 4] * alpha + p * bflo(w.z); o[8 * c + 5] = o[8 * c + 5] * alpha + p * bfhi(w.z); o[8 * c + 6] = o[8 * c + 6] * alpha + p * bflo(w.w); o[8 * c + 7] = o[8 * c + 7] * alpha + p * bfhi(w.w); }
        }
    }
    const float rl = 1.0f / l;
    v4u* op = (v4u*)(MIX + row * DM + h * 64);
#pragma unroll
    for (int c = 0; c < 8; ++c) { v4u w; w.x = pk2(o[8 * c + 0] * rl, o[8 * c + 1] * rl); w.y = pk2(o[8 * c + 2] * rl, o[8 * c + 3] * rl); w.z = pk2(o[8 * c + 4] * rl, o[8 * c + 5] * rl); w.w = pk2(o[8 * c + 6] * rl, o[8 * c + 7] * rl); op[c] = w; }
}
__device__ __forceinline__ void conv_phase(int gt, int NGT, const bf16* PROJ, const float* cw, bf16* MIX) {
    for (int i = gt; i < T * 32; i += NGT) {
        const int t = i >> 5, c0 = (i & 31) * 8, tp = t & (SEQ - 1);
        float y[8];
#pragma unroll
        for (int e = 0; e < 8; ++e) y[e] = 0.f;
#pragma unroll
        for (int j = 0; j < 3; ++j) { const int dt = 2 - j; if (tp - dt < 0) continue;
            const v4u cc = *(const v4u*)(PROJ + (size_t)(t - dt) * NPROJ + PC_CC + c0), ch = *(const v4u*)(PROJ + (size_t)(t - dt) * NPROJ + PC_CH + c0);
            const f32x4 w0 = *(const f32x4*)(cw + j * 256 + c0), w1 = *(const f32x4*)(cw + j * 256 + c0 + 4);
            y[0] += w0[0] * (bflo(cc.x) * bflo(ch.x)); y[1] += w0[1] * (bfhi(cc.x) * bfhi(ch.x)); y[2] += w0[2] * (bflo(cc.y) * bflo(ch.y)); y[3] += w0[3] * (bfhi(cc.y) * bfhi(ch.y));
            y[4] += w1[0] * (bflo(cc.z) * bflo(ch.z)); y[5] += w1[1] * (bfhi(cc.z) * bfhi(ch.z)); y[6] += w1[2] * (bflo(cc.w) * bflo(ch.w)); y[7] += w1[3] * (bfhi(cc.w) * bfhi(ch.w)); }
        const v4u cb = *(const v4u*)(PROJ + (size_t)t * NPROJ + PC_CB + c0);
        v4u o; o.x = pk2(y[0] * bflo(cb.x), y[1] * bfhi(cb.x)); o.y = pk2(y[2] * bflo(cb.y), y[3] * bfhi(cb.y)); o.z = pk2(y[4] * bflo(cb.z), y[5] * bfhi(cb.z)); o.w = pk2(y[6] * bflo(cb.w), y[7] * bfhi(cb.w));
        *(v4u*)(MIX + (size_t)t * DM + 512 + c0) = o;
    }
}
__device__ __forceinline__ void gla_naive_task(int lane_, const bf16* PROJ, const float* GZ, const float* wglr, const float* bglr, const float* gnorm, bf16* MIX, int bh, LAS float* scr) {
    const int lane = lane_, b = bh >> 2, h = bh & 3;
    LAS float* LA = scr; LAS float* LQ = scr + 64 * 36; LAS float* LK = scr + 2 * 64 * 36;
    float S[32];
#pragma unroll
    for (int k = 0; k < 32; ++k) S[k] = 0.f;
    const float gn = gnorm[h * 64 + lane];
    const float qscale = 0.17677669529663687f;
    for (int blk = 0; blk < SEQ / 64; ++blk) {
        const size_t row0 = (size_t)b * SEQ + blk * 64;
        {
            const size_t row = row0 + lane;
            float gz[16];
#pragma unroll
            for (int c = 0; c < 4; ++c) { const f32x4 g4 = *(const f32x4*)(GZ + row * 16 + 4 * c); gz[4 * c] = g4[0]; gz[4 * c + 1] = g4[1]; gz[4 * c + 2] = g4[2]; gz[4 * c + 3] = g4[3]; }
#pragma unroll 4
            for (int k = 0; k < 32; ++k) { float z = bglr[h * 32 + k];
#pragma unroll
                for (int r = 0; r < 16; ++r) z += gz[r] * wglr[r * 128 + h * 32 + k];
                const float ls = fminf(z, 0.f) - log1pf(expf(-fabsf(z)));
                LA[lane * 36 + k] = expf(ls * (1.0f / 16.0f)); }
            const bf16* qp = PROJ + row * NPROJ + PC_GQ + h * 32; const bf16* kp = PROJ + row * NPROJ + PC_GK + h * 32;
#pragma unroll
            for (int c = 0; c < 4; ++c) { const v4u wq = *(const v4u*)(qp + 8 * c), wk = *(const v4u*)(kp + 8 * c);
                LAS float* dq = LQ + lane * 36 + 8 * c; LAS float* dk = LK + lane * 36 + 8 * c;
                dq[0] = bflo(wq.x) * qscale; dq[1] = bfhi(wq.x) * qscale; dq[2] = bflo(wq.y) * qscale; dq[3] = bfhi(wq.y) * qscale; dq[4] = bflo(wq.z) * qscale; dq[5] = bfhi(wq.z) * qscale; dq[6] = bflo(wq.w) * qscale; dq[7] = bfhi(wq.w) * qscale;
                dk[0] = bflo(wk.x); dk[1] = bfhi(wk.x); dk[2] = bflo(wk.y); dk[3] = bfhi(wk.y); dk[4] = bflo(wk.z); dk[5] = bfhi(wk.z); dk[6] = bflo(wk.w); dk[7] = bfhi(wk.w); }
        }
        LDS_WAIT(); asm volatile("" ::: "memory");
        for (int g = 0; g < 4; ++g) {
            float vv[16], go[16];
#pragma unroll
            for (int i = 0; i < 16; ++i) { const size_t row = row0 + g * 16 + i; vv[i] = bf2f(PROJ[row * NPROJ + PC_GV + h * 64 + lane]); go[i] = bf2f(PROJ[row * NPROJ + PC_GO + h * 64 + lane]); }
#pragma unroll
            for (int i = 0; i < 16; ++i) { const int tl = g * 16 + i; float o = 0.f;
#pragma unroll
                for (int c = 0; c < 8; ++c) { const f32x4 a4 = *(const LAS f32x4*)(LA + tl * 36 + 4 * c), q4 = *(const LAS f32x4*)(LQ + tl * 36 + 4 * c), k4 = *(const LAS f32x4*)(LK + tl * 36 + 4 * c);
#pragma unroll
                    for (int e = 0; e < 4; ++e) { S[4 * c + e] = a4[e] * S[4 * c + e] + k4[e] * vv[i]; o += q4[e] * S[4 * c + e]; } }
                const float ssq = wave_sum(o * o);
                const float r = 1.0f / sqrtf(ssq * (1.0f / 64.0f) + EPS);
                const float gg = go[i];
                MIX[(row0 + tl) * DM + 768 + h * 64 + lane] = (bf16)f2bf(o * r * gn * (gg * sigmoidf_(gg))); }
        }
        LDS_WAIT(); asm volatile("" ::: "memory");
    }
}
__global__ void __launch_bounds__(256) naive_attn_kernel(const bf16* PROJ, bf16* MIX) {
    const int task = blockIdx.x * 4 + (threadIdx.x >> 6);
    if (task < NB * 8 * 128) attn_naive_task(PROJ, MIX, task, threadIdx.x & 63);
}
__global__ void __launch_bounds__(256) naive_conv_kernel(const bf16* PROJ, const float* cw, bf16* MIX) {
    conv_phase(blockIdx.x * 256 + threadIdx.x, gridDim.x * 256, PROJ, cw, MIX);
}
__global__ void __launch_bounds__(64) naive_gla_kernel(const bf16* PROJ, const float* GZ, const float* wglr, const float* bglr, const float* gnorm, bf16* MIX) {
    __shared__ __attribute__((aligned(16))) float scr[3 * 64 * 36];
    gla_naive_task(threadIdx.x, PROJ, GZ, wglr, bglr, gnorm, MIX, blockIdx.x, (LAS float*)scr);
}

__device__ __forceinline__ void router_phase(Frame& F) {
    const float* H = F.out; const float* ss = ss_arr(F, 3); const float* RG = (const float*)(F.ws + WS_RG);
    int* TOKE = (int*)(F.ws + WS_TOKE); float* TOKW = (float*)(F.ws + WS_TOKW); int* BLKCNT = (int*)(F.ws + WS_BLKCNT);
    LAS int* lcnt = (LAS int*)(F.lds + RING_OFF);
    const int lane = F.lane;
    float rg[16][8];
#pragma unroll
    for (int j = 0; j < 4; ++j)
#pragma unroll
        for (int i = 0; i < 4; ++i) { const int k = 256 * j + 4 * lane + i; const f32x4 a = *(const f32x4*)(RG + k * 8), b = *(const f32x4*)(RG + k * 8 + 4);
            rg[4 * j + i][0] = a[0]; rg[4 * j + i][1] = a[1]; rg[4 * j + i][2] = a[2]; rg[4 * j + i][3] = a[3]; rg[4 * j + i][4] = b[0]; rg[4 * j + i][5] = b[1]; rg[4 * j + i][6] = b[2]; rg[4 * j + i][7] = b[3]; }
    for (int grp = blockIdx.x; grp < T / 64; grp += F.G) {
        if (F.tid < 8) lcnt[F.tid] = 0;
        __syncthreads();
        for (int i = 0; i < 8; ++i) {
            const int t = grp * 64 + F.wave * 8 + i;
            const GAS f32x4* xr = (const GAS f32x4*)(H + (size_t)t * DM) + lane;
            float acc[8];
#pragma unroll
            for (int e = 0; e < 8; ++e) acc[e] = 0.f;
#pragma unroll
            for (int j = 0; j < 4; ++j) { const f32x4 v = xr[64 * j];
#pragma unroll
                for (int e = 0; e < 8; ++e) acc[e] += v[0] * rg[4 * j][e] + v[1] * rg[4 * j + 1][e] + v[2] * rg[4 * j + 2][e] + v[3] * rg[4 * j + 3][e]; }
#pragma unroll
            for (int e = 0; e < 8; ++e) acc[e] = wave_sum(acc[e]);
            const float rstd = row_rstd(ss, t);
            float l0 = -3.0e38f, l1 = -3.0e38f; int i0 = 0, i1 = 0;
#pragma unroll
            for (int e = 0; e < 8; ++e) { const float v = acc[e] * rstd; if (v > l0) { l1 = l0; i1 = i0; l0 = v; i0 = e; } else if (v > l1) { l1 = v; i1 = e; } }
            const float ex = expf(l1 - l0), w0 = 1.0f / (1.0f + ex), w1 = ex * w0;
            if (lane == 0) { TOKE[2 * t] = i0; TOKE[2 * t + 1] = i1; TOKW[2 * t] = w0; TOKW[2 * t + 1] = w1; atomicAdd((int*)&lcnt[i0], 1); atomicAdd((int*)&lcnt[i1], 1); }
        }
        __syncthreads();
        if (F.tid < 8) BLKCNT[grp * 8 + F.tid] = lcnt[F.tid];
        __syncthreads();
    }
}
__device__ __forceinline__ void dispatch_phase(Frame& F) {
    const int* BLKCNT = (const int*)(F.ws + WS_BLKCNT); const int* TOKE = (const int*)(F.ws + WS_TOKE); int* TOKS = (int*)(F.ws + WS_TOKS);
    float* SRSTD = (float*)(F.ws + WS_SRSTD); int* PANEL = (int*)(F.ws + WS_PANEL); const float* ss = ss_arr(F, 3);
    const bf16* HB = (const bf16*)(F.ws + WS_HB); bf16* ASORT = (bf16*)(F.ws + WS_ASORT);
    LAS int* L = (LAS int*)(F.lds + RING_OFF);
    for (int grp = blockIdx.x; grp < T / 64; grp += F.G) {
        for (int i = F.tid; i < 2048; i += NWAVES * 64) L[i] = BLKCNT[i];
        __syncthreads();
        if (F.tid < 8) { int tot = 0, pre = 0; for (int g = 0; g < 256; ++g) { const int c = L[g * 8 + F.tid]; tot += c; if (g < grp) pre += c; } L[2048 + F.tid] = tot; L[2056 + F.tid] = pre; }
        __syncthreads();
        if (F.tid == 0) { int base = 0; for (int e = 0; e < 8; ++e) { L[2064 + e] = base; const int np = (L[2048 + e] + 255) >> 8;
                if (grp == 0) for (int p = 0; p < np; ++p) PANEL[8 + (base >> 8) + p] = e;
                base += np << 8; }
            if (grp == 0) PANEL[0] = base >> 8; }
        if (F.tid < 128) L[2080 + F.tid] = TOKE[(grp * 64) * 2 + F.tid];
        __syncthreads();
        if (F.tid < 128) { const int a = F.tid, e = L[2080 + a]; int rank = 0; for (int a2 = 0; a2 < a; ++a2) rank += (L[2080 + a2] == e) ? 1 : 0;
            const int slot = L[2064 + e] + L[2056 + e] + rank; const int t = grp * 64 + (a >> 1);
            TOKS[2 * t + (a & 1)] = slot; SRSTD[slot] = row_rstd(ss, t); L[2208 + a] = slot; }
        if (grp == 0) { for (int e = 0; e < 8; ++e) { const int b0 = L[2064 + e] + L[2048 + e], b1 = L[2064 + e] + (((L[2048 + e] + 255) >> 8) << 8); for (int s = b0 + F.tid; s < b1; s += NWAVES * 64) SRSTD[s] = 0.f; } }
        __syncthreads();
        for (int a = F.wave; a < 128; a += NWAVES) { const int t = grp * 64 + (a >> 1), slot = L[2208 + a];
            const v4u* src = (const v4u*)(HB + (size_t)t * DM); v4u* dst = (v4u*)(ASORT + (size_t)slot * DM);
            const v4u v0 = src[F.lane], v1 = src[64 + F.lane]; dst[F.lane] = v0; dst[64 + F.lane] = v1; }
        __syncthreads();
    }
}
__device__ __forceinline__ void final_phase(Frame& F) {
    const int gw = F.vcu * NWAVES + F.wave, NGW = F.G * NWAVES, lane = F.lane;
    const int* TOKS = (const int*)(F.ws + WS_TOKS); const float* TOKW = (const float*)(F.ws + WS_TOKW); const bf16* Y = (const bf16*)(F.ws + WS_ASORT);
    const float* fn = F.in[I_FINALNORM];
    for (int t = gw; t < T; t += NGW) {
        const int s0 = TOKS[2 * t], s1 = TOKS[2 * t + 1]; const float w0 = TOKW[2 * t], w1 = TOKW[2 * t + 1];
        GAS f32x4* xr = (GAS f32x4*)(F.out + (size_t)t * DM) + lane;
        const GAS unsigned long long* y0 = (const GAS unsigned long long*)(Y + (size_t)s0 * DM) + lane; const GAS unsigned long long* y1 = (const GAS unsigned long long*)(Y + (size_t)s1 * DM) + lane;
        f32x4 v[4]; float s = 0.f;
#pragma unroll
        for (int j = 0; j < 4; ++j) { v[j] = xr[64 * j]; const unsigned long long a = y0[64 * j], b = y1[64 * j];
            v[j].x += w0 * bflo((unsigned)a) + w1 * bflo((unsigned)b); v[j].y += w0 * bfhi((unsigned)a) + w1 * bfhi((unsigned)b);
            v[j].z += w0 * bflo((unsigned)(a >> 32)) + w1 * bflo((unsigned)(b >> 32)); v[j].w += w0 * bfhi((unsigned)(a >> 32)) + w1 * bfhi((unsigned)(b >> 32));
            s += (v[j].x * v[j].x + v[j].y * v[j].y) + (v[j].z * v[j].z + v[j].w * v[j].w); }
        s = wave_sum(s);
        const float rstd = 1.0f / sqrtf(s * (1.0f / DM) + EPS);
#pragma unroll
        for (int j = 0; j < 4; ++j) { const f32x4 g = *((const f32x4*)fn + lane + 64 * j); xr[64 * j] = v[j] * rstd * g; }
    }
}

struct Args { const float* in[17]; float* out; unsigned char* ws; int ph_lo, ph_hi; };
constexpr int N_PHASES = 16;
#ifndef MK_ONE_LAUNCH
#define MK_ONE_LAUNCH 0
#endif

__global__ void __launch_bounds__(NWAVES * 64, 2) mega_fwd(Args args) {
    extern __shared__ __attribute__((aligned(16))) unsigned char lds[];
    Frame F;
    F.lds = (LAS unsigned char*)lds;
    F.MISC = (volatile LAS unsigned*)(F.lds + MISC_OFF);
    F.tid = threadIdx.x; F.lane = F.tid & 63; F.wave = __builtin_amdgcn_readfirstlane(F.tid >> 6);
    F.G = gridDim.x; { const int bx = blockIdx.x; F.vcu = (F.G % 8 == 0) ? (bx % 8) * (F.G / 8) + bx / 8 : bx; }
    F.ws = args.ws; F.ctl = (gu32*)(args.ws + WS_CTL); F.out = args.out;
#pragma unroll
    for (int i = 0; i < 17; ++i) F.in[i] = args.in[i];
    for (int u = F.tid; u < (LDS_BYTES - LDSCTL_OFF) / 4; u += NWAVES * 64) ((LAS unsigned*)(F.lds + LDSCTL_OFF))[u] = 0u;
    __syncthreads();
    XcdBarrier bar; bar.bar = (unsigned*)(F.ctl + CW_BAR); bar.x = 0; bar.st = nullptr;
    if (MK_ONE_LAUNCH) bar = xcd_barrier_post((unsigned*)(F.ctl + CW_BAR), F.MISC + 8);
    const int lo = args.ph_lo, hi = args.ph_hi;
#define IN(k) (lo <= (k) && (k) < hi)
#define SEAM(k) do { if (IN(k) && IN((k) + 1)) xcd_barrier(bar); } while (0)

    bf16* HB = (bf16*)(F.ws + WS_HB); bf16* PROJ = (bf16*)(F.ws + WS_PROJ); bf16* MIX = (bf16*)(F.ws + WS_MIX);

    if (IN(0)) { p0_prologue(F); } SEAM(0);

#define MIXER_LAYER(l) do { constexpr int pb = 1 + 5 * (l); \
        if (IN(pb)) { \
            pg8::Gemm g{HB, (const bf16*)(F.ws + WS_WIN) + (size_t)(l) * NPROJ * DM, T, NPROJ, DM}; pg8::StaticOrder S; S.init(T, NPROJ, F.G, (int)blockIdx.x); \
            pg8::EpiProj E{PROJ, ss_arr(F, 2 * (l)), (const float*)(F.ws + WS_ROPE)}; \
            pg8::gemm_phase<pg8::EpiProj, pg8::StaticOrder, true, true>(F.lds + RING_OFF, g, S, E); \
            gz_phase(F, HB, (const bf16*)(F.ws + WS_WGZ) + (size_t)(l) * 16 * DM, ss_arr(F, 2 * (l)), (float*)(F.ws + WS_GZ)); \
        } \
        SEAM(pb); \
        if (IN(pb + 1)) {   } \
        SEAM(pb + 1); \
        if (IN(pb + 2)) { \
            pg8::Gemm g{MIX, (const bf16*)(F.ws + WS_WOUT) + (size_t)(l) * DM * DM, T, DM, DM}; pg8::StaticOrder S; S.init(T, DM, F.G, (int)blockIdx.x); \
            pg8::EpiResid E{(l) == 0 ? F.in[I_X] : F.out, F.out, HB, ss_arr(F, 2 * (l) + 1)}; \
            pg8::gemm_phase<pg8::EpiResid, pg8::StaticOrder, true, true>(F.lds + RING_OFF, g, S, E); \
        } \
        SEAM(pb + 2); } while (0)

    MIXER_LAYER(0);
    if (IN(4)) {
        pg8::Gemm g{HB, (const bf16*)(F.ws + WS_WGU), T, 2 * FFD, DM}; pg8::StaticOrder S; S.init(T, 2 * FFD, F.G, (int)blockIdx.x);
        pg8::EpiSwiglu E{(bf16*)(F.ws + WS_ACT), FFD, ss_arr(F, 1), nullptr, 0, 22};
        pg8::gemm_phase<pg8::EpiSwiglu, pg8::StaticOrder, true, true>(F.lds + RING_OFF, g, S, E);
    }
    SEAM(4);
    if (IN(5)) {
        pg8::Gemm g{(const bf16*)(F.ws + WS_ACT), (const bf16*)(F.ws + WS_WD), T, DM, FFD}; pg8::StaticOrder S; S.init(T, DM, F.G, (int)blockIdx.x);
        pg8::EpiResid E{F.out, F.out, HB, ss_arr(F, 2)};
        pg8::gemm_phase<pg8::EpiResid, pg8::StaticOrder, true, true>(F.lds + RING_OFF, g, S, E);
    }
    SEAM(5);
    MIXER_LAYER(1);
    if (IN(9)) { router_phase(F); } SEAM(9);
    if (IN(10)) { dispatch_phase(F); } SEAM(10);
#define MOE_BATCH(bt) do { const int* PANEL = (const int*)(F.ws + WS_PANEL); constexpr int pu = 11 + 2 * (bt); \
        if (IN(pu)) { \
            const int npan = PANEL[0]; const int p0 = (bt) * MOE_PB; int np = npan - p0; np = np < 0 ? 0 : (np > MOE_PB ? MOE_PB : np); \
            pg8::Gemm g{(const bf16*)(F.ws + WS_ASORT), (const bf16*)(F.ws + WS_EGU), 0, 0, DM}; pg8::MoeOrder S; S.init(np, 28, F.G, (int)blockIdx.x, p0, PANEL + 8); \
            pg8::EpiSwiglu E{(bf16*)(F.ws + WS_EACT), FFE, nullptr, (const float*)(F.ws + WS_SRSTD), p0 * 256, 28}; \
            pg8::gemm_phase<pg8::EpiSwiglu, pg8::MoeOrder, true, true>(F.lds + RING_OFF, g, S, E); \
        } \
        SEAM(pu); \
        if (IN(pu + 1)) { \
            const int npan = PANEL[0]; const int p0 = (bt) * MOE_PB; int np = npan - p0; np = np < 0 ? 0 : (np > MOE_PB ? MOE_PB : np); \
            pg8::Gemm g{(const bf16*)(F.ws + WS_EACT) - (size_t)p0 * 256 * FFE, (const bf16*)(F.ws + WS_ED), 0, 0, FFE}; pg8::MoeOrder S; S.init(np, 4, F.G, (int)blockIdx.x, p0, PANEL + 8); \
            pg8::EpiMoeDown E{(bf16*)(F.ws + WS_ASORT)}; \
            pg8::gemm_phase<pg8::EpiMoeDown, pg8::MoeOrder, true, true>(F.lds + RING_OFF, g, S, E); \
        } \
        SEAM(pu + 1); } while (0)
    MOE_BATCH(0);
    MOE_BATCH(1);
    if (IN(15)) { final_phase(F); }
#undef IN
#undef SEAM
}

extern "C" void kernel_launch(void* const* d_in, const int* in_sizes, int n_in, void* d_out, int out_size, void* d_ws, size_t ws_size, hipStream_t stream) {
    static int grid = 0;
    if (grid == 0) {
        if (n_in != 17 || out_size != T * DM || ws_size < WS_END) { fprintf(stderr, "kernel_launch: unexpected shapes (n_in %d, out %d, ws %zu)\n", n_in, out_size, ws_size); grid = -1; return; }
        int dev = 0, cus = 0;
        if (hipGetDevice(&dev) != hipSuccess || hipDeviceGetAttribute(&cus, hipDeviceAttributeMultiprocessorCount, dev) != hipSuccess) { grid = -1; return; }
        if (hipFuncSetAttribute((const void*)mega_fwd, hipFuncAttributeMaxDynamicSharedMemorySize, LDS_BYTES) != hipSuccess) { grid = -1; return; }
        (void)hipGetLastError();
        grid = cus;
    }
    if (grid < 0) return;
    (void)hipMemsetAsync((char*)d_ws + WS_CTL, 0, CTL_ZERO_BYTES, stream);
    Args a{};
    for (int i = 0; i < 17; ++i) a.in[i] = (const float*)d_in[i];
    a.out = (float*)d_out; a.ws = (unsigned char*)d_ws;
#if MK_ONE_LAUNCH
    a.ph_lo = 0; a.ph_hi = N_PHASES;
    hipLaunchKernelGGL(mega_fwd, dim3(grid), dim3(NWAVES * 64), LDS_BYTES, stream, a);
#else
    for (int p = 0; p < N_PHASES; ++p) {
        if (p == 2 || p == 7) { const int l = (p == 2) ? 0 : 1;
            const bf16* PROJ = (const bf16*)((unsigned char*)d_ws + WS_PROJ); bf16* MIX = (bf16*)((unsigned char*)d_ws + WS_MIX);
            hipLaunchKernelGGL(naive_conv_kernel, dim3(1024), dim3(256), 0, stream, PROJ, a.in[I_CONVW] + l * 3 * 256, MIX);
            hipLaunchKernelGGL(naive_gla_kernel, dim3(8), dim3(64), 0, stream, PROJ, (const float*)((unsigned char*)d_ws + WS_GZ), a.in[I_WGLR] + l * 16 * 128, a.in[I_BGLR] + l * 128, a.in[I_GLANORM] + l * 256, MIX);
            hipLaunchKernelGGL(naive_attn_kernel, dim3(512), dim3(256), 0, stream, PROJ, MIX);
            continue; }
        a.ph_lo = p; a.ph_hi = p + 1; hipLaunchKernelGGL(mega_fwd, dim3(grid), dim3(NWAVES * 64), LDS_BYTES, stream, a); }
#endif
}
```

```cpp
#include <hip/hip_runtime.h>
#include <cstdio>
#include <cstdint>
#include <cmath>
#ifndef PROBE_REP
#define PROBE_REP (-1)
#endif
#ifndef PROBE_T
#define PROBE_T (-1)
#endif
namespace pg8 {
#define PG8_LAS __attribute__((address_space(3)))
typedef unsigned short bf16_t;
typedef short bf16x8 __attribute__((ext_vector_type(8)));
typedef float f32x4 __attribute__((ext_vector_type(4)));
typedef unsigned u32x4 __attribute__((ext_vector_type(4)));
constexpr int BM = 256, BK = 64, HALF = 128, HTB = HALF * BK * 2  , STAGE_BYTES = 8 * HTB, NXCD = 8, WGM = 8;

__host__ __device__ __forceinline__ int lds_byte(int r, int c) { const int st = (r >> 4) * 2 + (c >> 5), rr = r & 15, cc = c & 31, ob = rr * 64 + cc * 2; return st * 1024 + (ob ^ (((ob >> 9) & 1) << 5)); }
__host__ __device__ __forceinline__ void stage_rc(int b, int& R, int& C) { const int st = b / 1024, sb = b % 1024, swz = sb ^ (((sb >> 9) & 1) << 5); R = (st >> 1) * 16 + swz / 64; C = (st & 1) * 32 + (swz % 64) / 2; }
__host__ __device__ __forceinline__ int perm32(int rho) { const int n = rho >> 4, i = rho & 15; return 8 * (i >> 2) + 4 * n + (i & 3); }

struct Unit { int pm, pn; int kb = 0, nk = 0, mode = 0, slot = 0; };
struct Gemm { const bf16_t* A; const bf16_t* Bt; int M, N, K; };

struct StaticOrder {
    int nM, nN, nwg, G, c;
    __host__ __device__ void init(int M, int N, int G_, int c_) { nM = M / BM; nN = N / BM; nwg = nM * nN; G = G_; c = c_; }
    __host__ __device__ bool next(int i, Unit& u) const {
        const long L = (long)i * G + c; if (L >= nwg) return false;
        int wgid = (int)L; { const int q = nwg / NXCD, r = nwg % NXCD, xcd = wgid % NXCD, off = wgid / NXCD; wgid = (xcd < r ? xcd * (q + 1) : r * (q + 1) + (xcd - r) * q) + off; }
        const int nig = WGM * nN, gid = wgid / nig, fm = gid * WGM, gsz = (nM - fm) < WGM ? (nM - fm) : WGM;
        u.pm = fm + ((wgid % nig) % gsz); u.pn = (wgid % nig) / gsz; u.slot = i; return true;
    }
    __device__ __forceinline__ void a_ready(const Unit&) const {}
    __device__ __forceinline__ void done(const Unit&) const {}
};

__device__ __forceinline__ unsigned cvt_pk_bf16(float lo, float hi) { unsigned r; asm volatile("v_cvt_pk_bf16_f32 %0, %1, %2" : "=v"(r) : "v"(lo), "v"(hi)); return r; }
template <class Epi, class Sched, bool ALIGN_EPI = false, bool SP2 = false, int PITCH = 0  >
__device__ __forceinline__ void gemm_phase(PG8_LAS unsigned char* lds, const Gemm g, const Sched& S, const Epi& E) {
    const int tid = threadIdx.x, wid = __builtin_amdgcn_readfirstlane(tid >> 6), lane = tid & 63, wr = wid >> 2, wc = wid & 3, fr = lane & 15, fq = lane >> 4;
    const int K = g.K, nt = K / BK, RP = PITCH ? PITCH : K;
    unsigned voffA[2], voffB[2];
#pragma unroll
    for (int i = 0; i < 2; ++i) { int R, C; stage_rc(tid * 16 + i * 8192, R, C); const int Rb = Epi::PERM ? ((R & ~31) + perm32(R & 31)) : R;
        voffA[i] = (unsigned)(R * RP + C) * 2u; voffB[i] = (unsigned)(Rb * RP + C) * 2u; }
    const size_t kstep = (size_t)(BK * 2);
    const size_t hstep = (size_t)HALF * RP * 2;
    const size_t tstep = 2 * hstep;
    const unsigned ldsw = (unsigned)wid * 1024u;
    const int aoff = lds_byte(wr * 64 + fr, fq * 8), boff = lds_byte(wc * 32 + fr, fq * 8);
#define PG8_SA(b, h) (((b) * 2 + (h)) * HTB)
#define PG8_SB(b, h) ((4 + (b) * 2 + (h)) * HTB)
#define PG8_STAGE(bufoff, gbase, voff) do { _Pragma("unroll") for (int _i = 0; _i < 2; ++_i) \
        __builtin_amdgcn_global_load_lds((const unsigned*)((const char*)(gbase) + (voff)[_i]), (PG8_LAS unsigned*)(lds + (bufoff) + ldsw + _i * 8192), 16, 0, 0); } while (0)
#define PG8_LDA(dst, b, h) do { _Pragma("unroll") for (int m = 0; m < 4; ++m) _Pragma("unroll") for (int k = 0; k < 2; ++k) dst[m][k] = *(const PG8_LAS bf16x8*)(lds + PG8_SA(b, h) + aoff + m * 2048 + k * 1024); } while (0)
#define PG8_LDB(dst, b, h) do { _Pragma("unroll") for (int n = 0; n < 2; ++n) _Pragma("unroll") for (int k = 0; k < 2; ++k) dst[n][k] = *(const PG8_LAS bf16x8*)(lds + PG8_SB(b, h) + boff + n * 2048 + k * 1024); } while (0)
#define PG8_MMA(ai, bj, At, Bt) do { __builtin_amdgcn_s_setprio(1); _Pragma("unroll") for (int m = 0; m < 4; ++m) _Pragma("unroll") for (int n = 0; n < 2; ++n) _Pragma("unroll") for (int k = 0; k < 2; ++k) \
        acc[ai][bj][m][n] = __builtin_amdgcn_mfma_f32_16x16x32_bf16(Bt[n][k], At[m][k], acc[ai][bj][m][n], 0, 0, 0); __builtin_amdgcn_s_setprio(0); } while (0)
#define PG8_WAIT_V(n) asm volatile("s_waitcnt vmcnt(" #n ")" ::: "memory")
#define PG8_WAIT_L(n) asm volatile("s_waitcnt lgkmcnt(" #n ")" ::: "memory")
#define PG8_BAR __builtin_amdgcn_s_barrier()
#define PG8_SCHED __builtin_amdgcn_sched_barrier(0)
    Unit cur, nxt; int ui = 0;
    if (!S.next(0, cur)) return;
    f32x4 acc[2][2][4][2];
    if constexpr (Epi::SK) { E.init_acc(acc, cur, wid); } else {
#pragma unroll
    for (int a = 0; a < 2; ++a)
#pragma unroll
        for (int b = 0; b < 2; ++b)
#pragma unroll
            for (int m = 0; m < 4; ++m)
#pragma unroll
                for (int n = 0; n < 2; ++n) acc[a][b][m][n] = (f32x4){0.f, 0.f, 0.f, 0.f};
    }
    bf16x8 At[4][2], B0[2][2], B1[2][2];
    const char* cA = (const char*)g.A + (size_t)cur.pm * tstep + (size_t)cur.kb * kstep; const char* cB = (const char*)g.Bt + (size_t)cur.pn * tstep + (size_t)cur.kb * kstep;
    S.a_ready(cur);
    if constexpr (SP2) {
        PG8_STAGE(PG8_SB(0, 0), cB, voffB); PG8_STAGE(PG8_SB(0, 1), cB + hstep, voffB); PG8_STAGE(PG8_SA(0, 0), cA, voffA); PG8_STAGE(PG8_SA(0, 1), cA + hstep, voffA);
        if (wr == 1) PG8_BAR;
        PG8_WAIT_V(2); PG8_BAR;
        PG8_STAGE(PG8_SB(1, 0), cB + kstep, voffB); PG8_STAGE(PG8_SA(1, 0), cA + kstep, voffA); PG8_STAGE(PG8_SB(1, 1), cB + hstep + kstep, voffB);
        PG8_WAIT_V(6); PG8_BAR;
    } else {
        PG8_STAGE(PG8_SB(0, 0), cB, voffB); PG8_STAGE(PG8_SA(0, 0), cA, voffA); PG8_STAGE(PG8_SB(0, 1), cB + hstep, voffB); PG8_STAGE(PG8_SA(0, 1), cA + hstep, voffA);
        if (wr == 1) PG8_BAR;
        PG8_WAIT_V(4); PG8_BAR;
        PG8_STAGE(PG8_SB(1, 0), cB + kstep, voffB); PG8_STAGE(PG8_SA(1, 0), cA + kstep, voffA); PG8_STAGE(PG8_SB(1, 1), cB + hstep + kstep, voffB);
        PG8_WAIT_V(6); PG8_BAR;
    }
    for (;;) {
        const bool has_next = S.next(ui + 1, nxt);
        const char* nA = has_next ? (const char*)g.A + (size_t)nxt.pm * tstep + (size_t)nxt.kb * kstep : cA; const char* nB = has_next ? (const char*)g.Bt + (size_t)nxt.pn * tstep + (size_t)nxt.kb * kstep : cB;
        const int ntc = cur.nk ? cur.nk : nt;
        for (int t = 0; t < ntc; t += 2) {
            const bool last = (t == ntc - 2);
            const char* a1 = cA + (size_t)(t + 1) * kstep;
            const char* a2 = last ? nA : cA + (size_t)(t + 2) * kstep; const char* b2 = last ? nB : cB + (size_t)(t + 2) * kstep;
            const char* a3 = a2 + kstep; const char* b3 = b2 + kstep;
            if (last && has_next) S.a_ready(nxt);
            if constexpr (SP2) {
            PG8_LDB(B0, 0, 0); PG8_LDB(B1, 0, 1); PG8_SCHED; PG8_LDA(At, 0, 0); PG8_STAGE(PG8_SA(1, 1), a1 + hstep, voffA);
            PG8_WAIT_V(8); PG8_WAIT_L(0); PG8_BAR; PG8_MMA(0, 0, At, B0); PG8_MMA(0, 1, At, B1); PG8_BAR; PG8_SCHED;
            PG8_LDA(At, 0, 1); PG8_STAGE(PG8_SB(0, 0), b2, voffB); PG8_STAGE(PG8_SB(0, 1), b2 + hstep, voffB); PG8_STAGE(PG8_SA(0, 0), a2, voffA);
            PG8_WAIT_V(8); PG8_WAIT_L(0); PG8_BAR; PG8_MMA(1, 0, At, B0); PG8_MMA(1, 1, At, B1); PG8_BAR; PG8_SCHED;
            PG8_LDB(B0, 1, 0); PG8_LDB(B1, 1, 1); PG8_SCHED; PG8_LDA(At, 1, 0); PG8_STAGE(PG8_SA(0, 1), a2 + hstep, voffA);
            PG8_WAIT_V(8); PG8_WAIT_L(0); PG8_BAR; PG8_MMA(0, 0, At, B0); PG8_MMA(0, 1, At, B1); PG8_BAR; PG8_SCHED;
            PG8_LDA(At, 1, 1); PG8_STAGE(PG8_SB(1, 0), b3, voffB); PG8_STAGE(PG8_SB(1, 1), b3 + hstep, voffB); PG8_STAGE(PG8_SA(1, 0), a3, voffA);
            PG8_WAIT_V(8); PG8_WAIT_L(0); PG8_BAR; PG8_MMA(1, 0, At, B0); PG8_MMA(1, 1, At, B1); PG8_BAR; PG8_SCHED;
            } else {
            PG8_LDB(B0, 0, 0); PG8_SCHED; PG8_LDA(At, 0, 0); PG8_STAGE(PG8_SA(1, 1), a1 + hstep, voffA);
            PG8_WAIT_L(8); PG8_BAR; PG8_WAIT_L(0); PG8_MMA(0, 0, At, B0); PG8_BAR; PG8_SCHED;
            PG8_LDB(B1, 0, 1); PG8_STAGE(PG8_SB(0, 0), b2, voffB);
            PG8_BAR; PG8_WAIT_L(0); PG8_MMA(0, 1, At, B1); PG8_BAR;
            PG8_LDA(At, 0, 1); PG8_STAGE(PG8_SA(0, 0), a2, voffA);
            PG8_BAR; PG8_WAIT_L(0); PG8_MMA(1, 0, At, B0); PG8_BAR; PG8_SCHED;
            PG8_STAGE(PG8_SB(0, 1), b2 + hstep, voffB);
            PG8_WAIT_V(6); PG8_BAR; PG8_MMA(1, 1, At, B1); PG8_BAR;
            PG8_LDB(B0, 1, 0); PG8_SCHED; PG8_LDA(At, 1, 0); PG8_STAGE(PG8_SA(0, 1), a2 + hstep, voffA);
            PG8_WAIT_L(8); PG8_BAR; PG8_WAIT_L(0); PG8_MMA(0, 0, At, B0); PG8_BAR; PG8_SCHED;
            PG8_LDB(B1, 1, 1); PG8_STAGE(PG8_SB(1, 0), b3, voffB);
            PG8_BAR; PG8_WAIT_L(0); PG8_MMA(0, 1, At, B1); PG8_BAR;
            PG8_LDA(At, 1, 1); PG8_STAGE(PG8_SA(1, 0), a3, voffA);
            PG8_BAR; PG8_WAIT_L(0); PG8_MMA(1, 0, At, B0); PG8_BAR; PG8_SCHED;
            PG8_STAGE(PG8_SB(1, 1), b3 + hstep, voffB);
            PG8_WAIT_V(6); PG8_BAR; PG8_MMA(1, 1, At, B1); PG8_BAR;
            }
        }
        if constexpr (ALIGN_EPI) { if (wr == 0) PG8_BAR; }
        if constexpr (!Epi::AFTER_DRAIN) { E(acc, cur, wr, wc, fr, fq); S.done(cur); }
        if (!has_next) break;
        if constexpr (Epi::SK) { E.init_acc(acc, nxt, wid); } else {
#pragma unroll
        for (int a = 0; a < 2; ++a)
#pragma unroll
            for (int b = 0; b < 2; ++b)
#pragma unroll
                for (int m = 0; m < 4; ++m)
#pragma unroll
                    for (int n = 0; n < 2; ++n) acc[a][b][m][n] = (f32x4){0.f, 0.f, 0.f, 0.f};
        }
        cur = nxt; cA = nA; cB = nB; ++ui;
        if constexpr (ALIGN_EPI) { if (wr == 1) PG8_BAR; }
    }
    PG8_WAIT_V(0);
    if constexpr (!ALIGN_EPI) { if (wr == 0) PG8_BAR; }
    PG8_BAR;
    if constexpr (Epi::AFTER_DRAIN) { E.fused(acc, cur, wr, wc, fr, fq, lds, wid, lane); S.done(cur); }
#undef PG8_SA
#undef PG8_SB
#undef PG8_STAGE
#undef PG8_LDA
#undef PG8_LDB
#undef PG8_MMA
#undef PG8_WAIT_V
#undef PG8_WAIT_L
#undef PG8_BAR
#undef PG8_SCHED
}
typedef int i32x4 __attribute__((ext_vector_type(4)));
typedef int i32x8 __attribute__((ext_vector_type(8)));
template <class Epi, class Sched, bool ALIGN_EPI, bool SP2, int PITCH = 0>
__device__ __forceinline__ void gemm_phase8(PG8_LAS unsigned char* lds, const Gemm g, const Sched& S, const Epi& E, const int wid  ) {
    int lane; asm volatile("v_mbcnt_lo_u32_b32 %0, -1, 0\n\tv_mbcnt_hi_u32_b32 %0, -1, %0" : "=v"(lane));
    const int tid = wid * 64 + lane, wr = wid >> 2, wc = wid & 3, fr = lane & 15, fq = lane >> 4;
    const int K = g.K, rowb = PITCH ? PITCH : K, nt = K / 128;
    unsigned voffA[2], voffB[2];
#pragma unroll
    for (int i = 0; i < 2; ++i) { int R, C; stage_rc(tid * 16 + i * 8192, R, C); const int Rb = Epi::PERM ? ((R & ~31) + perm32(R & 31)) : R;
        voffA[i] = (unsigned)(R * rowb + C * 2); voffB[i] = (unsigned)(Rb * rowb + C * 2); }
    const size_t kstep = (size_t)(BK * 2);
    const size_t hstep = (size_t)HALF * rowb;
    const size_t tstep = 2 * hstep;
    const unsigned ldsw = (unsigned)wid * 1024u;
    const unsigned ldsbase_ = (unsigned)__builtin_amdgcn_readfirstlane((int)((unsigned)(unsigned long long)(const void*)lds + ldsw));
    const int c8 = 32 * (fq >> 1) + 16 * (fq & 1);
    const int aoff0 = lds_byte(wr * 64 + fr, c8), boff0 = lds_byte(wc * 32 + fr, c8);
#define PG8_SA(b, h) (((b) * 2 + (h)) * HTB)
#define PG8_SB(b, h) ((4 + (b) * 2 + (h)) * HTB)
#define PG8_STAGE(bufoff, gbase, voff) do { _Pragma("unroll") for (int _i = 0; _i < 2; ++_i) { unsigned keep_; \
        asm volatile("s_mov_b32 %0, m0\n\ts_mov_b32 m0, %1\n\ts_nop 0\n\tglobal_load_lds_dwordx4 %2, %3\n\ts_mov_b32 m0, %0" : "=&s"(keep_) : "s"(ldsbase_ + (unsigned)((bufoff) + _i * 8192)), "v"((voff)[_i]), "s"((const char*)(gbase)) : "memory"); } } while (0)
#define PG8_LDA(dst, b, h) do { _Pragma("unroll") for (int m = 0; m < 4; ++m) dst[m] = *(const PG8_LAS i32x8*)(lds + PG8_SA(b, h) + aoff0 + m * 2048); } while (0)
#define PG8_LDB(dst, b, h) do { _Pragma("unroll") for (int n = 0; n < 2; ++n) dst[n] = *(const PG8_LAS i32x8*)(lds + PG8_SB(b, h) + boff0 + n * 2048); } while (0)
#define PG8_MMA(ai, bj, At, Bt) do { __builtin_amdgcn_s_setprio(1); _Pragma("unroll") for (int m = 0; m < 4; ++m) _Pragma("unroll") for (int n = 0; n < 2; ++n) \
        acc[ai][bj][m][n] = __builtin_amdgcn_mfma_scale_f32_16x16x128_f8f6f4(Bt[n], At[m], acc[ai][bj][m][n], 0, 0, 0, 0, 0, 0);     __builtin_amdgcn_s_setprio(0); } while (0)
#define PG8_WAIT_V(n) asm volatile("s_waitcnt vmcnt(" #n ")" ::: "memory")
#define PG8_WAIT_L(n) asm volatile("s_waitcnt lgkmcnt(" #n ")" ::: "memory")
#define PG8_BAR __builtin_amdgcn_s_barrier()
#define PG8_SCHED __builtin_amdgcn_sched_barrier(0)
    Unit cur, nxt; int ui = 0;
    if (!S.next(0, cur)) return;
    f32x4 acc[2][2][4][2];
    if constexpr (Epi::SK) { E.init_acc(acc, cur, wid); } else {
#pragma unroll
    for (int a = 0; a < 2; ++a)
#pragma unroll
        for (int b = 0; b < 2; ++b)
#pragma unroll
            for (int m = 0; m < 4; ++m)
#pragma unroll
                for (int n = 0; n < 2; ++n) acc[a][b][m][n] = (f32x4){0.f, 0.f, 0.f, 0.f};
    }
    i32x8 At[4], B0[2], B1[2];
    const char* cA = (const char*)g.A + (size_t)cur.pm * tstep + (size_t)cur.kb * kstep; const char* cB = (const char*)g.Bt + (size_t)cur.pn * tstep + (size_t)cur.kb * kstep;
    S.a_ready(cur);
    if constexpr (SP2) {
        PG8_STAGE(PG8_SB(0, 0), cB, voffB); PG8_STAGE(PG8_SB(0, 1), cB + hstep, voffB); PG8_STAGE(PG8_SA(0, 0), cA, voffA); PG8_STAGE(PG8_SA(0, 1), cA + hstep, voffA);
        if (wr == 1) PG8_BAR;
        PG8_WAIT_V(2); PG8_BAR;
        PG8_STAGE(PG8_SB(1, 0), cB + kstep, voffB); PG8_STAGE(PG8_SA(1, 0), cA + kstep, voffA); PG8_STAGE(PG8_SB(1, 1), cB + hstep + kstep, voffB);
        PG8_WAIT_V(6); PG8_BAR;
    } else {
        PG8_STAGE(PG8_SB(0, 0), cB, voffB); PG8_STAGE(PG8_SA(0, 0), cA, voffA); PG8_STAGE(PG8_SB(0, 1), cB + hstep, voffB); PG8_STAGE(PG8_SA(0, 1), cA + hstep, voffA);
        if (wr == 1) PG8_BAR;
        PG8_WAIT_V(4); PG8_BAR;
        PG8_STAGE(PG8_SB(1, 0), cB + kstep, voffB); PG8_STAGE(PG8_SA(1, 0), cA + kstep, voffA); PG8_STAGE(PG8_SB(1, 1), cB + hstep + kstep, voffB);
        PG8_WAIT_V(6); PG8_BAR;
    }
    for (;;) {
        const bool has_next = S.next(ui + 1, nxt);
        const char* nA = has_next ? (const char*)g.A + (size_t)nxt.pm * tstep + (size_t)nxt.kb * kstep : cA; const char* nB = has_next ? (const char*)g.Bt + (size_t)nxt.pn * tstep + (size_t)nxt.kb * kstep : cB;
        const int ntc = cur.nk ? cur.nk : nt;
        for (int t = 0; t < ntc; t += 2) {
            const bool last = (t == ntc - 2);
            const char* a1 = cA + (size_t)(t + 1) * kstep;
            const char* a2 = last ? nA : cA + (size_t)(t + 2) * kstep; const char* b2 = last ? nB : cB + (size_t)(t + 2) * kstep;
            const char* a3 = a2 + kstep; const char* b3 = b2 + kstep;
            if (last && has_next) S.a_ready(nxt);
            if constexpr (SP2) {
            PG8_LDB(B0, 0, 0); PG8_LDB(B1, 0, 1); PG8_SCHED; PG8_LDA(At, 0, 0); PG8_STAGE(PG8_SA(1, 1), a1 + hstep, voffA);
            PG8_WAIT_V(8); PG8_WAIT_L(0); PG8_BAR; PG8_MMA(0, 0, At, B0); PG8_MMA(0, 1, At, B1); PG8_BAR; PG8_SCHED;
            PG8_LDA(At, 0, 1); PG8_STAGE(PG8_SB(0, 0), b2, voffB); PG8_STAGE(PG8_SB(0, 1), b2 + hstep, voffB); PG8_STAGE(PG8_SA(0, 0), a2, voffA);
            PG8_WAIT_V(8); PG8_WAIT_L(0); PG8_BAR; PG8_MMA(1, 0, At, B0); PG8_MMA(1, 1, At, B1); PG8_BAR; PG8_SCHED;
            PG8_LDB(B0, 1, 0); PG8_LDB(B1, 1, 1); PG8_SCHED; PG8_LDA(At, 1, 0); PG8_STAGE(PG8_SA(0, 1), a2 + hstep, voffA);
            PG8_WAIT_V(8); PG8_WAIT_L(0); PG8_BAR; PG8_MMA(0, 0, At, B0); PG8_MMA(0, 1, At, B1); PG8_BAR; PG8_SCHED;
            PG8_LDA(At, 1, 1); PG8_STAGE(PG8_SB(1, 0), b3, voffB); PG8_STAGE(PG8_SB(1, 1), b3 + hstep, voffB); PG8_STAGE(PG8_SA(1, 0), a3, voffA);
            PG8_WAIT_V(8); PG8_WAIT_L(0); PG8_BAR; PG8_MMA(1, 0, At, B0); PG8_MMA(1, 1, At, B1); PG8_BAR; PG8_SCHED;
            } else {
            PG8_LDB(B0, 0, 0); PG8_SCHED; PG8_LDA(At, 0, 0); PG8_STAGE(PG8_SA(1, 1), a1 + hstep, voffA);
            PG8_WAIT_L(8); PG8_BAR; PG8_WAIT_L(0); PG8_MMA(0, 0, At, B0); PG8_BAR; PG8_SCHED;
            PG8_LDB(B1, 0, 1); PG8_STAGE(PG8_SB(0, 0), b2, voffB);
            PG8_BAR; PG8_WAIT_L(0); PG8_MMA(0, 1, At, B1); PG8_BAR;
            PG8_LDA(At, 0, 1); PG8_STAGE(PG8_SA(0, 0), a2, voffA);
            PG8_BAR; PG8_WAIT_L(0); PG8_MMA(1, 0, At, B0); PG8_BAR; PG8_SCHED;
            PG8_STAGE(PG8_SB(0, 1), b2 + hstep, voffB);
            PG8_WAIT_V(6); PG8_BAR; PG8_MMA(1, 1, At, B1); PG8_BAR;
            PG8_LDB(B0, 1, 0); PG8_SCHED; PG8_LDA(At, 1, 0); PG8_STAGE(PG8_SA(0, 1), a2 + hstep, voffA);
            PG8_WAIT_L(8); PG8_BAR; PG8_WAIT_L(0); PG8_MMA(0, 0, At, B0); PG8_BAR; PG8_SCHED;
            PG8_LDB(B1, 1, 1); PG8_STAGE(PG8_SB(1, 0), b3, voffB);
            PG8_BAR; PG8_WAIT_L(0); PG8_MMA(0, 1, At, B1); PG8_BAR;
            PG8_LDA(At, 1, 1); PG8_STAGE(PG8_SA(1, 0), a3, voffA);
            PG8_BAR; PG8_WAIT_L(0); PG8_MMA(1, 0, At, B0); PG8_BAR; PG8_SCHED;
            PG8_STAGE(PG8_SB(1, 1), b3 + hstep, voffB);
            PG8_WAIT_V(6); PG8_BAR; PG8_MMA(1, 1, At, B1); PG8_BAR;
            }
        }
        if constexpr (ALIGN_EPI) { if (wr == 0) PG8_BAR; }
        if constexpr (!Epi::AFTER_DRAIN) { int fr_ = fr, fq_ = fq; asm volatile("" : "+v"(fr_), "+v"(fq_));
            E(acc, cur, wr, wc, fr_, fq_); S.done(cur); }
        if (!has_next) break;
        if constexpr (Epi::SK) { E.init_acc(acc, nxt, wid); } else {
#pragma unroll
        for (int a = 0; a < 2; ++a)
#pragma unroll
            for (int b = 0; b < 2; ++b)
#pragma unroll
                for (int m = 0; m < 4; ++m)
#pragma unroll
                    for (int n = 0; n < 2; ++n) acc[a][b][m][n] = (f32x4){0.f, 0.f, 0.f, 0.f};
        }
        cur = nxt; cA = nA; cB = nB; ++ui;
        if constexpr (ALIGN_EPI) { if (wr == 1) PG8_BAR; }
    }
    PG8_WAIT_V(0);
    if constexpr (!ALIGN_EPI) { if (wr == 0) PG8_BAR; }
    PG8_BAR;
    if constexpr (Epi::AFTER_DRAIN) { E.fused(acc, cur, wr, wc, fr, fq, lds, wid, lane); S.done(cur); }
#undef PG8_SA
#undef PG8_SB
#undef PG8_STAGE
#undef PG8_LDA
#undef PG8_LDB
#undef PG8_MMA
#undef PG8_WAIT_V
#undef PG8_WAIT_L
#undef PG8_BAR
#undef PG8_SCHED
}
}
#define GAS __attribute__((address_space(1)))
#define LAS __attribute__((address_space(3)))
typedef unsigned short bf16;
typedef unsigned v4u __attribute__((ext_vector_type(4)));
typedef float f32x4 __attribute__((ext_vector_type(4)));
typedef short bf16x8 __attribute__((ext_vector_type(8)));
typedef GAS unsigned gu32;
typedef GAS unsigned long long gu64;
#define RLX_AGENT __ATOMIC_RELAXED, __HIP_MEMORY_SCOPE_AGENT
#define LDS_WAIT() asm volatile("s_waitcnt lgkmcnt(0)" ::: "memory")
#define VM_WAIT() asm volatile("s_waitcnt vmcnt(0)" ::: "memory")
__device__ __forceinline__ unsigned long long rt() { return __builtin_amdgcn_s_memrealtime(); }
__device__ __forceinline__ unsigned f2bf(float f) { unsigned u = __builtin_bit_cast(unsigned, f); return (u + 0x7fffu + ((u >> 16) & 1u)) >> 16; }
__device__ __forceinline__ unsigned pk2(float lo, float hi) { return f2bf(lo) | (f2bf(hi) << 16); }

#define XB_TMO      128
#define XB_XCNT(j)  (256  + 64 * (j))
#define XB_XSUB(j)  (1280 + 64 * (j))
#define XB_XGEN(j)  (2304 + 64 * (j))
#define XB_TOP      3328
#define XB_TOPGEN   3392
#define XCD_BAR_WORDS 3456
#define XB_SPIN_CAP (1u << 18)

__device__ __forceinline__ unsigned xb_ld(unsigned* p)              { return __hip_atomic_load(p, __ATOMIC_RELAXED, __HIP_MEMORY_SCOPE_AGENT); }
__device__ __forceinline__ unsigned xb_add(unsigned* p, unsigned v) { return __hip_atomic_fetch_add(p, v, __ATOMIC_RELAXED, __HIP_MEMORY_SCOPE_AGENT); }
__device__ __forceinline__ unsigned xb_xcc_id() { return (unsigned)__builtin_amdgcn_s_getreg((3 << 11) | 20) & 0xFu; }
#define XB_SPIN(cond, bar) do { unsigned _sp = 0; while (cond) { __builtin_amdgcn_s_sleep(1); \
    if ((++_sp & 255u) == 0u) { if (xb_ld(&(bar)[XB_TMO])) break; if (_sp > XB_SPIN_CAP) { atomicAdd(&(bar)[XB_TMO], 1u); break; } } } } while (0)

struct XcdBarrier {
    unsigned* bar; unsigned x;
    volatile LAS unsigned* st;
};

__device__ __forceinline__ XcdBarrier xcd_barrier_post(unsigned* bar, volatile LAS unsigned* st) {
    XcdBarrier b; b.bar = bar; b.x = xb_xcc_id(); b.st = st;
    if (threadIdx.x == 0) (void)xb_add(&bar[XB_XCNT(b.x)], 1u);
    return b;
}
__device__ __forceinline__ void xcd_barrier_complete(unsigned* bar, unsigned x, unsigned& nloc, unsigned& nx) {
    const unsigned G = gridDim.x * gridDim.y * gridDim.z;
    unsigned sum, cnt, mine, sp = 0u;
    for (;;) {
        sum = 0u; cnt = 0u; mine = 0u;
#pragma unroll
        for (unsigned j = 0; j < 16; ++j) { const unsigned c = xb_ld(&bar[XB_XCNT(j)]); sum += c; cnt += (c > 0u) ? 1u : 0u; mine = (j == x) ? c : mine; }
        if (sum == G) break;
        __builtin_amdgcn_s_sleep(1);
        if ((++sp & 255u) == 0u) { if (xb_ld(&bar[XB_TMO])) break; if (sp > XB_SPIN_CAP) { atomicAdd(&bar[XB_TMO], 1u); break; } }
    }
    nloc = mine > 0u ? mine : 1u; nx = cnt > 0u ? cnt : 1u;
}

__device__ __forceinline__ void xcd_barrier(const XcdBarrier& b, const bool leader_thread  ) {
    asm volatile("s_waitcnt vmcnt(0)" ::: "memory");
    __syncthreads();
    if (leader_thread) {
        unsigned* bar = b.bar;
        __builtin_amdgcn_s_waitcnt(0);
        unsigned nloc = b.st[0], nx = b.st[1];
        if (nloc == 0u) { xcd_barrier_complete(bar, b.x, nloc, nx); b.st[0] = nloc; b.st[1] = nx; }
        const unsigned old = xb_add(&bar[XB_XSUB(b.x)], 1u);
        const unsigned gen = old / nloc;
        if (old + 1u == (gen + 1u) * nloc) {
            __builtin_amdgcn_fence(__ATOMIC_RELEASE, "agent");
            asm volatile("s_waitcnt vmcnt(0)" ::: "memory");
            const unsigned og = xb_add(&bar[XB_TOP], 1u);
            const unsigned tg = og / nx;
            if (og + 1u == (tg + 1u) * nx) xb_add(&bar[XB_TOPGEN], 1u);
            else XB_SPIN(xb_ld(&bar[XB_TOPGEN]) == tg, bar);
            __builtin_amdgcn_fence(__ATOMIC_ACQUIRE, "agent");
            xb_add(&bar[XB_XGEN(b.x)], 1u);
            asm volatile("s_waitcnt vmcnt(0)" ::: "memory");
        } else {
            XB_SPIN(xb_ld(&bar[XB_XGEN(b.x)]) == gen, bar);
            __builtin_amdgcn_fence(__ATOMIC_ACQUIRE, "agent");
            asm volatile("s_waitcnt vmcnt(0)" ::: "memory");
        }
    }
    __syncthreads();
}

constexpr int NB = 2, SEQ = 8192, T = NB * SEQ, DM = 1024;
constexpr int NPROJ = 3072, INTOT = 3088;
constexpr int FFD = 2816, FFE = 3584, NEXP = 8;
constexpr float EPS = 1e-6f;
constexpr float LOG2E = 1.4426950408889634f;
constexpr float C2Q = 0.125f * LOG2E;
constexpr int PC_Q = 0, PC_K = 512, PC_V = 1024, PC_CB = 1536, PC_CC = 1792, PC_CH = 2048, PC_GQ = 2304, PC_GK = 2432, PC_GV = 2560, PC_GO = 2816;
constexpr int NWAVES = 8;
constexpr int MOE_MAXSLOT = 34816;

constexpr size_t MiB = 1u << 20;
constexpr size_t WS_CTL = 0, CTL_ZERO_BYTES = 1 * MiB;
constexpr size_t WS_ROPE = 1 * MiB;
constexpr size_t WS_RG = 3 * MiB;
constexpr size_t WS_WGZ = 3 * MiB + 64 * 1024;
constexpr size_t WS_BLKCNT = 3 * MiB + 128 * 1024;
constexpr size_t WS_PANEL = 3 * MiB + 192 * 1024;
constexpr size_t WS_TOKE = 4 * MiB;
constexpr size_t WS_TOKW = 4 * MiB + 128 * 1024;
constexpr size_t WS_TOKS = 4 * MiB + 256 * 1024;
constexpr size_t WS_SRSTD = 4 * MiB + 384 * 1024;
constexpr size_t WS_GZ = 5 * MiB;
constexpr size_t WS_WIN = 6 * MiB;
constexpr size_t WS_WOUT = 18 * MiB;
constexpr size_t WS_WGU = 22 * MiB;
constexpr size_t WS_WD = 33 * MiB;
constexpr size_t WS_EGU = 39 * MiB;
constexpr size_t WS_ED = 95 * MiB;
constexpr int FFE_PITCH = 3712;
constexpr size_t WS_HB = 124 * MiB;
constexpr size_t WS_SSP = 156 * MiB;
constexpr size_t WS_DYN = 160 * MiB;
constexpr size_t WS_PROJ = WS_DYN;
constexpr size_t WS_MIX = WS_DYN + 96 * MiB;
constexpr size_t WS_ACT = WS_DYN;
constexpr int FFD_PITCH = 2880;
constexpr size_t WS_ASORT = WS_DYN;
constexpr size_t WS_Y = WS_DYN + 34 * MiB;
constexpr size_t WS_EACT = WS_DYN + 102 * MiB;
constexpr size_t WS_END = WS_DYN + 226 * MiB;
constexpr size_t WS_SKP_FFN = WS_DYN + 100 * MiB;
constexpr float W8_UP = 32.f, W8_DN = 64.f;
constexpr int CW_TMO = 0, CW_BAR = 4096, CW_SKF = 8192;

constexpr int RING_OFF = 0, RING_BYTES = 131072;
constexpr int LDSCTL_OFF = 135168, MISC_OFF = LDSCTL_OFF + 320;
constexpr int LDS_BYTES = 147456;

__device__ __forceinline__ float bf2f(unsigned short b) { return __uint_as_float(((unsigned)b) << 16); }
__device__ __forceinline__ float bflo(unsigned w) { return __uint_as_float(w << 16); }
__device__ __forceinline__ float bfhi(unsigned w) { return __uint_as_float(w & 0xffff0000u); }
__device__ __forceinline__ float wave_sum(float v) {
#pragma unroll
    for (int o = 1; o < 64; o <<= 1) v += __shfl_xor(v, o);
    return v;
}
__device__ __forceinline__ float fast_exp2(float x) { return __builtin_amdgcn_exp2f(x); }
__device__ __forceinline__ float fast_rcp(float x) { return __builtin_amdgcn_rcpf(x); }
__device__ __forceinline__ float sigmoidf_(float x) { return fast_rcp(1.0f + fast_exp2(-x * LOG2E)); }

__device__ __forceinline__ float row_rstd(const float* ssp, int row) {
    const float4 a = *(const float4*)(ssp + (size_t)row * 16), b = *(const float4*)(ssp + (size_t)row * 16 + 4), c = *(const float4*)(ssp + (size_t)row * 16 + 8), d = *(const float4*)(ssp + (size_t)row * 16 + 12);
    const float s = ((a.x + a.y) + (a.z + a.w)) + ((b.x + b.y) + (b.z + b.w)) + ((c.x + c.y) + (c.z + c.w)) + ((d.x + d.y) + (d.z + d.w));
    return 1.0f / sqrtf(s * (1.0f / DM) + EPS);
}

constexpr int RSTD_CACHE_OFF = LDSCTL_OFF + 4608, RSTD_CACHE_MAX = 6;

namespace pg8 {
struct EpiProj {
    static constexpr bool PERM = true, AFTER_DRAIN = false, SK = false;
    bf16_t* O; const PG8_LAS float* rc; const float* rope;
    __device__ __forceinline__ void operator()(const f32x4 (&acc)[2][2][4][2], const Unit& u, int wr, int wc, int fr, int fq) const {
        const int row0 = u.pm * BM + wr * 64 + fr, colb = u.pn * BM + wc * 32 + 8 * fq;
        const bool isrope = u.pn < 4; const float qs = (u.pn < 2) ? C2Q : 1.0f;
        const int i0 = 16 * (wc & 1) + 4 * fq;
        f32x4 csv[16];
#pragma unroll
        for (int q = 0; q < 16; ++q) csv[q] = (f32x4){1.f, 0.f, 1.f, 0.f};
        if (isrope) {
#pragma unroll
            for (int q = 0; q < 8; ++q) { const int row = row0 + (q >> 2) * HALF + (q & 3) * 16; const float* rp = rope + ((size_t)(row & (SEQ - 1)) * 32 + i0) * 2; csv[2 * q] = *(const f32x4*)rp; csv[2 * q + 1] = *(const f32x4*)(rp + 4); }
            asm volatile("" : "+v"(csv[0]), "+v"(csv[1]), "+v"(csv[2]), "+v"(csv[3]), "+v"(csv[4]), "+v"(csv[5]), "+v"(csv[6]), "+v"(csv[7]), "+v"(csv[8]), "+v"(csv[9]), "+v"(csv[10]), "+v"(csv[11]), "+v"(csv[12]), "+v"(csv[13]), "+v"(csv[14]), "+v"(csv[15]));
        }
#pragma unroll
        for (int ai = 0; ai < 2; ++ai)
#pragma unroll
            for (int m = 0; m < 4; ++m) {
                const int row = row0 + ai * HALF + m * 16;
                const float rstd = rc[u.slot * 256 + wr * 64 + fr + ai * HALF + m * 16];
                const f32x4 cs0 = csv[2 * (ai * 4 + m)], cs1 = csv[2 * (ai * 4 + m) + 1];
                bf16_t* rowp = O + (size_t)row * NPROJ + colb;
#pragma unroll
                for (int bj = 0; bj < 2; ++bj) {
                    f32x4 v0 = acc[ai][bj][m][0] * rstd, v1 = acc[ai][bj][m][1] * rstd;
                    if (isrope) {
                        f32x4 w0, w1;
                        w0[0] = v0[0] * cs0[0] - v0[1] * cs0[1]; w0[1] = v0[0] * cs0[1] + v0[1] * cs0[0];
                        w0[2] = v0[2] * cs0[2] - v0[3] * cs0[3]; w0[3] = v0[2] * cs0[3] + v0[3] * cs0[2];
                        w1[0] = v1[0] * cs1[0] - v1[1] * cs1[1]; w1[1] = v1[0] * cs1[1] + v1[1] * cs1[0];
                        w1[2] = v1[2] * cs1[2] - v1[3] * cs1[3]; w1[3] = v1[2] * cs1[3] + v1[3] * cs1[2];
                        v0 = w0 * qs; v1 = w1 * qs;
                    }
                    u32x4 w; w.x = cvt_pk_bf16(v0[0], v0[1]); w.y = cvt_pk_bf16(v0[2], v0[3]); w.z = cvt_pk_bf16(v1[0], v1[1]); w.w = cvt_pk_bf16(v1[2], v1[3]);
                    *(u32x4*)(rowp + bj * HALF) = w;
                }
            }
    }
};
struct EpiResid {
    static constexpr bool PERM = true, AFTER_DRAIN = false, SK = false;
    bf16_t* hb; float* ssout;
    __device__ __forceinline__ void operator()(const f32x4 (&acc)[2][2][4][2], const Unit& u, int wr, int wc, int fr, int fq) const {
        const int row0 = u.pm * BM + wr * 64 + fr, colb = u.pn * BM + wc * 32 + 8 * fq;
        u32x4 bv[16];
#pragma unroll
        for (int q = 0; q < 16; ++q) bv[q] = *(const u32x4*)(hb + (size_t)(row0 + (q >> 3) * HALF + ((q >> 1) & 3) * 16) * DM + colb + (q & 1) * HALF);
        asm volatile("" : "+v"(bv[0]), "+v"(bv[1]), "+v"(bv[2]), "+v"(bv[3]), "+v"(bv[4]), "+v"(bv[5]), "+v"(bv[6]), "+v"(bv[7]), "+v"(bv[8]), "+v"(bv[9]), "+v"(bv[10]), "+v"(bv[11]), "+v"(bv[12]), "+v"(bv[13]), "+v"(bv[14]), "+v"(bv[15]));
#pragma unroll
        for (int ai = 0; ai < 2; ++ai)
#pragma unroll
            for (int m = 0; m < 4; ++m) {
                const int row = row0 + ai * HALF + m * 16; const size_t off = (size_t)row * DM + colb; float sq = 0.f;
#pragma unroll
                for (int bj = 0; bj < 2; ++bj) {
                    const u32x4 b = bv[ai * 8 + m * 2 + bj];
                    const f32x4 v0 = acc[ai][bj][m][0] + (f32x4){bflo(b.x), bfhi(b.x), bflo(b.y), bfhi(b.y)}, v1 = acc[ai][bj][m][1] + (f32x4){bflo(b.z), bfhi(b.z), bflo(b.w), bfhi(b.w)};
                    u32x4 w; w.x = cvt_pk_bf16(v0[0], v0[1]); w.y = cvt_pk_bf16(v0[2], v0[3]); w.z = cvt_pk_bf16(v1[0], v1[1]); w.w = cvt_pk_bf16(v1[2], v1[3]);
                    *(u32x4*)(hb + off + bj * HALF) = w;
                    const float r0 = bflo(w.x), r1 = bfhi(w.x), r2 = bflo(w.y), r3 = bfhi(w.y), r4 = bflo(w.z), r5 = bfhi(w.z), r6 = bflo(w.w), r7 = bfhi(w.w);
                    sq += (r0 * r0 + r1 * r1) + (r2 * r2 + r3 * r3) + (r4 * r4 + r5 * r5) + (r6 * r6 + r7 * r7);
                }
                sq += __shfl_xor(sq, 16); sq += __shfl_xor(sq, 32);
                if (fq == 0) ssout[(size_t)row * 16 + u.pn * 4 + wc] = sq;
            }
    }
};
__device__ __forceinline__ unsigned pk4_fp8(float a, float b, float c, float d) {
    a = fminf(fmaxf(a, -448.f), 448.f); b = fminf(fmaxf(b, -448.f), 448.f); c = fminf(fmaxf(c, -448.f), 448.f); d = fminf(fmaxf(d, -448.f), 448.f);
    int p = 0; p = __builtin_amdgcn_cvt_pk_fp8_f32(a, b, p, false); p = __builtin_amdgcn_cvt_pk_fp8_f32(c, d, p, true); return (unsigned)p; }
struct EpiSwiglu8 {
    static constexpr bool PERM = true, AFTER_DRAIN = false, SK = false;
    unsigned char* O; int ldo; const float* rstdv; int row_off; int ntile;
    __device__ __forceinline__ void operator()(const f32x4 (&acc)[2][2][4][2], const Unit& u, int wr, int wc, int fr, int fq) const {
        const int row0 = u.pm * BM + wr * 64 + fr, col = (u.pn % ntile) * HALF + wc * 32 + 8 * fq;
        float rsv[8];
#pragma unroll
        for (int q = 0; q < 8; ++q) rsv[q] = rstdv[row0 + (q >> 2) * HALF + (q & 3) * 16];
        asm volatile("" : "+v"(rsv[0]), "+v"(rsv[1]), "+v"(rsv[2]), "+v"(rsv[3]), "+v"(rsv[4]), "+v"(rsv[5]), "+v"(rsv[6]), "+v"(rsv[7]));
#pragma unroll
        for (int ai = 0; ai < 2; ++ai)
#pragma unroll
            for (int m = 0; m < 4; ++m) {
                const int row = row0 + ai * HALF + m * 16;
                const float rstd = rsv[ai * 4 + m] * (1.0f / W8_UP);
                float a[8];
#pragma unroll
                for (int n = 0; n < 2; ++n)
#pragma unroll
                    for (int j = 0; j < 4; ++j) { const float g = acc[ai][0][m][n][j] * rstd, uu = acc[ai][1][m][n][j] * rstd; a[n * 4 + j] = g * sigmoidf_(g) * uu; }
                typedef unsigned u32x2 __attribute__((ext_vector_type(2)));
                u32x2 w; w.x = pk4_fp8(a[0], a[1], a[2], a[3]); w.y = pk4_fp8(a[4], a[5], a[6], a[7]);
                *(u32x2*)(O + (size_t)(row - row_off) * ldo + col) = w;
            }
    }
};
struct EpiSwiglu {
    static constexpr bool PERM = true, AFTER_DRAIN = false, SK = false;
    bf16_t* O; int ldo; const PG8_LAS float* rc; const float* rstdv; int row_off; int ntile;
    __device__ __forceinline__ void operator()(const f32x4 (&acc)[2][2][4][2], const Unit& u, int wr, int wc, int fr, int fq) const {
        const int row0 = u.pm * BM + wr * 64 + fr, col = (u.pn % ntile) * HALF + wc * 32 + 8 * fq;
        float rsv[8];
#pragma unroll
        for (int q = 0; q < 8; ++q) { const int rr = (q >> 2) * HALF + (q & 3) * 16; rsv[q] = rstdv ? rstdv[row0 + rr] : rc[u.slot * 256 + wr * 64 + fr + rr]; }
        asm volatile("" : "+v"(rsv[0]), "+v"(rsv[1]), "+v"(rsv[2]), "+v"(rsv[3]), "+v"(rsv[4]), "+v"(rsv[5]), "+v"(rsv[6]), "+v"(rsv[7]));
#pragma unroll
        for (int ai = 0; ai < 2; ++ai)
#pragma unroll
            for (int m = 0; m < 4; ++m) {
                const int row = row0 + ai * HALF + m * 16;
                const float rstd = rsv[ai * 4 + m];
                float a[8];
#pragma unroll
                for (int n = 0; n < 2; ++n)
#pragma unroll
                    for (int j = 0; j < 4; ++j) { const float g = acc[ai][0][m][n][j] * rstd, uu = acc[ai][1][m][n][j] * rstd; a[n * 4 + j] = g * sigmoidf_(g) * uu; }
                u32x4 w; w.x = cvt_pk_bf16(a[0], a[1]); w.y = cvt_pk_bf16(a[2], a[3]); w.z = cvt_pk_bf16(a[4], a[5]); w.w = cvt_pk_bf16(a[6], a[7]);
                *(u32x4*)(O + (size_t)(row - row_off) * ldo + col) = w;
            }
    }
};
struct EpiMoeDown {
    static constexpr bool PERM = true, AFTER_DRAIN = false, SK = false;
    bf16_t* Y; float sc;
    __device__ __forceinline__ void operator()(const f32x4 (&acc)[2][2][4][2], const Unit& u, int wr, int wc, int fr, int fq) const {
        const int row0 = u.pm * BM + wr * 64 + fr, colb = (u.pn & 3) * BM + wc * 32 + 8 * fq;
#pragma unroll
        for (int ai = 0; ai < 2; ++ai)
#pragma unroll
            for (int m = 0; m < 4; ++m) {
                const int row = row0 + ai * HALF + m * 16;
#pragma unroll
                for (int bj = 0; bj < 2; ++bj) {
                    const f32x4 v0 = acc[ai][bj][m][0] * sc, v1 = acc[ai][bj][m][1] * sc;
                    u32x4 w; w.x = cvt_pk_bf16(v0[0], v0[1]); w.y = cvt_pk_bf16(v0[2], v0[3]); w.z = cvt_pk_bf16(v1[0], v1[1]); w.w = cvt_pk_bf16(v1[2], v1[3]);
                    *(u32x4*)(Y + (size_t)row * DM + colb + bj * HALF) = w;
                }
            }
    }
};
struct MoeOrder {
    int nM, nN, nwg, G, c, p0; const int* pexp;
    __device__ void init(int np, int nN_, int G_, int c_, int p0_, const int* pexp_) { nM = np; nN = nN_; nwg = nM * nN; G = G_; c = c_; p0 = p0_; pexp = pexp_; }
    __device__ bool next(int i, Unit& u) const {
        const long L = (long)i * G + c; if (L >= nwg) return false;
        int wgid = (int)L; { const int q = nwg / NXCD, r = nwg % NXCD, xcd = wgid % NXCD, off = wgid / NXCD; wgid = (xcd < r ? xcd * (q + 1) : r * (q + 1) + (xcd - r) * q) + off; }
        const int nig = WGM * nN, gid = wgid / nig, fm = gid * WGM, gsz = (nM - fm) < WGM ? (nM - fm) : WGM;
        const int pm = p0 + fm + ((wgid % nig) % gsz), pn = (wgid % nig) / gsz;
        u.pm = pm; u.pn = pexp[pm] * nN + pn; return true;
    }
    __device__ __forceinline__ void a_ready(const Unit&) const {}
    __device__ __forceinline__ void done(const Unit&) const {}
};

struct DenseMap { int nM, nN; __device__ __forceinline__ void map(int idx, Unit& u) const { const int nig = WGM * nN, gid = idx / nig, fm = gid * WGM, gsz = (nM - fm) < WGM ? (nM - fm) : WGM; u.pm = fm + ((idx % nig) % gsz); u.pn = (idx % nig) / gsz; } };
struct MoeMap { int nM, nN, p0; const int* pexp; __device__ __forceinline__ void map(int idx, Unit& u) const { const int nig = WGM * nN, gid = idx / nig, fm = gid * WGM, gsz = (nM - fm) < WGM ? (nM - fm) : WGM; const int pm = p0 + fm + ((idx % nig) % gsz); u.pm = pm; u.pn = pexp[pm] * nN + (idx % nig) / gsz; } };
constexpr int SK_TAB_OFF = LDSCTL_OFF + 1024, SK_TAB_MAX = 48;
template <class Map> __device__ __forceinline__ void sk_build(PG8_LAS int* tab, const Map& M, int U, int P, int G, int bid, float* part0, float* part1, int split, unsigned* flags, const bool leader_thread) {
    if (leader_thread) {
        int NX = 8, x = bid % 8, ci = bid / 8, ncx = G / 8; if (G % 8) { NX = 1; x = 0; ci = bid; ncx = G; }
        const int q = U / NX, r = U % NX, qx = q + (x < r ? 1 : 0), Sx = (x < r) ? x * (q + 1) : r * (q + 1) + (x - r) * q;
        int Rdp = q / ncx - 1; if (Rdp < 0) Rdp = 0;
        int n = 0;
#define SK_PUT(idx_, kb_, nk_, mode_, sl_) do { Unit u_; M.map((idx_), u_); PG8_LAS int* t_ = tab + 16 * n; t_[0] = u_.pm; t_[1] = u_.pn; t_[2] = (kb_); t_[3] = (nk_); t_[4] = (mode_); \
            const int s_ = (sl_); const unsigned long long sa_ = (unsigned long long)((s_ < split) ? part0 + (size_t)s_ * 65536 : part1 + (size_t)(s_ - split) * 65536), fa_ = (unsigned long long)(flags + s_ * 16); \
            t_[6] = (int)sa_; t_[7] = (int)(sa_ >> 32); t_[8] = (int)fa_; t_[9] = (int)(fa_ >> 32); ++n; } while (0)
        for (int i = 0; i < Rdp; ++i) SK_PUT(Sx + i * ncx + ci, 0, 0, 0, 0);
        const int remx = qx - Rdp * ncx, b0 = Sx + Rdp * ncx, TP = remx * P, base = TP / ncx, remn = TP % ncx;
        if (P <= 0 || base < P) {     for (int j = ci; j < remx && n < SK_TAB_MAX; j += ncx) SK_PUT(b0 + j, 0, 0, 0, 0); }
        else {
            const int s = ci * base + (ci < remn ? ci : remn), e = s + base + (ci < remn ? 1 : 0);
            const int u0 = s / P, p0 = s % P, u1 = e / P, p1 = e % P, first_full = p0 ? u0 + 1 : u0;
            if (p0) SK_PUT(b0 + u0, 2 * p0, 2 * (P - p0), 1, bid);
            for (int qq = first_full; qq < u1 && n < SK_TAB_MAX - 1; ++qq) SK_PUT(b0 + qq, 0, 0, 0, 0);
            if (p1) SK_PUT(b0 + u1, 0, 2 * p1, 2, bid + NX);
        }
#undef SK_PUT
        tab[-16] = n;
    }
    __syncthreads();
}
struct TabOrder {
    unsigned taddr;
    __device__ __forceinline__ explicit TabOrder(const PG8_LAS int* tab) : taddr((unsigned)__builtin_amdgcn_readfirstlane((int)(unsigned)(unsigned long long)(const void*)tab)) {}
    __device__ __forceinline__ bool next(int i, Unit& u) const {
        const PG8_LAS int* hdr = (const PG8_LAS int*)(unsigned long long)(taddr - 64u);
        if (i >= __builtin_amdgcn_readfirstlane(hdr[0])) return false;
        const PG8_LAS int* t = (const PG8_LAS int*)(unsigned long long)(taddr + 64u * (unsigned)i);
        u.pm = __builtin_amdgcn_readfirstlane(t[0]); u.pn = __builtin_amdgcn_readfirstlane(t[1]); u.kb = __builtin_amdgcn_readfirstlane(t[2]); u.nk = __builtin_amdgcn_readfirstlane(t[3]); u.mode = __builtin_amdgcn_readfirstlane(t[4]); u.slot = i; return true;
    }
    __device__ __forceinline__ void a_ready(const Unit&) const {}
    __device__ __forceinline__ void done(const Unit&) const {}
};
template <class Epi> struct EpiSK {
    static constexpr bool PERM = Epi::PERM, AFTER_DRAIN = false, SK = true;
    Epi E; unsigned taddr; unsigned* tmo;
    static __device__ __forceinline__ int tid_now(int wid) { int l_; asm volatile("v_mbcnt_lo_u32_b32 %0, -1, 0\n\tv_mbcnt_hi_u32_b32 %0, -1, %0" : "=v"(l_)); return wid * 64 + l_; }
    __device__ __forceinline__ void init_acc(f32x4 (&acc)[2][2][4][2], const Unit& u, int wid) const {
        if (u.mode != 2) {
#pragma unroll
            for (int a = 0; a < 2; ++a)
#pragma unroll
                for (int b = 0; b < 2; ++b)
#pragma unroll
                    for (int m = 0; m < 4; ++m)
#pragma unroll
                        for (int n = 0; n < 2; ++n) acc[a][b][m][n] = (f32x4){0.f, 0.f, 0.f, 0.f};
            return;
        }
        const int tid = tid_now(wid);
        const PG8_LAS int* t = (const PG8_LAS int*)(unsigned long long)(taddr + 64u * (unsigned)u.slot);
        const unsigned slo = (unsigned)__builtin_amdgcn_readfirstlane(t[6]), shi = (unsigned)__builtin_amdgcn_readfirstlane(t[7]), flo = (unsigned)__builtin_amdgcn_readfirstlane(t[8]), fhi = (unsigned)__builtin_amdgcn_readfirstlane(t[9]);
        const __amdgpu_buffer_rsrc_t rs = __builtin_amdgcn_make_buffer_rsrc((void*)(((unsigned long long)shi << 32) | slo), 0, 262144, 0x00020000);
        unsigned* fl = (unsigned*)(((unsigned long long)fhi << 32) | flo);
        { const unsigned long long t0 = __builtin_amdgcn_s_memrealtime();
          while ((unsigned)__builtin_amdgcn_readfirstlane((int)__hip_atomic_load(fl, __ATOMIC_RELAXED, __HIP_MEMORY_SCOPE_AGENT)) < 8u) {
              if (__builtin_amdgcn_s_memrealtime() - t0 > 2000000ull) { if ((tid & 63) == 0) __hip_atomic_store(tmo, 1u, __ATOMIC_RELAXED, __HIP_MEMORY_SCOPE_AGENT); break; }
              __builtin_amdgcn_s_sleep(2); } }
#pragma unroll
        for (int ai = 0; ai < 2; ++ai)
#pragma unroll
            for (int bj = 0; bj < 2; ++bj)
#pragma unroll
                for (int m = 0; m < 4; ++m)
#pragma unroll
                    for (int n = 0; n < 2; ++n) acc[ai][bj][m][n] = __builtin_bit_cast(f32x4, __builtin_amdgcn_raw_buffer_load_b128(rs, (unsigned)(tid * 16), ((((ai * 2 + bj) * 4 + m) * 2 + n) * 8192), 16));
        asm volatile("s_waitcnt vmcnt(0)" ::: "memory");
    }
    __device__ __forceinline__ void operator()(f32x4 (&acc)[2][2][4][2], const Unit& u, int wr, int wc, int fr, int fq) const {
        if (u.mode == 1) {
            const int tid = tid_now(wr * 4 + wc);
            const PG8_LAS int* t = (const PG8_LAS int*)(unsigned long long)(taddr + 64u * (unsigned)u.slot);
            const unsigned slo = (unsigned)__builtin_amdgcn_readfirstlane(t[6]), shi = (unsigned)__builtin_amdgcn_readfirstlane(t[7]), flo = (unsigned)__builtin_amdgcn_readfirstlane(t[8]), fhi = (unsigned)__builtin_amdgcn_readfirstlane(t[9]);
            const __amdgpu_buffer_rsrc_t rs = __builtin_amdgcn_make_buffer_rsrc((void*)(((unsigned long long)shi << 32) | slo), 0, 262144, 0x00020000);
            unsigned* fl = (unsigned*)(((unsigned long long)fhi << 32) | flo);
#pragma unroll
            for (int ai = 0; ai < 2; ++ai)
#pragma unroll
                for (int bj = 0; bj < 2; ++bj)
#pragma unroll
                    for (int m = 0; m < 4; ++m)
#pragma unroll
                        for (int n = 0; n < 2; ++n) __builtin_amdgcn_raw_buffer_store_b128(__builtin_bit_cast(u32x4, acc[ai][bj][m][n]), rs, (unsigned)(tid * 16), ((((ai * 2 + bj) * 4 + m) * 2 + n) * 8192), 16);
            asm volatile("s_waitcnt vmcnt(0)" ::: "memory");
            if ((tid & 63) == 0) __hip_atomic_fetch_add(fl, 1u, __ATOMIC_RELAXED, __HIP_MEMORY_SCOPE_AGENT);
            return;
        }
        E(acc, u, wr, wc, fr, fq);
    }
};
}

struct Frame {
    LAS unsigned char* lds;
    volatile LAS unsigned* MISC;
    gu32* ctl;
    int tid, lane, wave;
    int vcu, G;
    unsigned char* ws;
    const float* in[17];
    float* out;
};
enum { I_X = 0, I_MIXNORM, I_WIN, I_WGLR, I_BGLR, I_CONVW, I_GLANORM, I_WOUT, I_FFNNORM, I_DWG, I_DWU, I_DWD, I_ROUTER, I_EWG, I_EWU, I_EWD, I_FINALNORM };

__device__ __forceinline__ float* ss_arr(Frame& F, int k) { return (float*)(F.ws + WS_SSP) + (size_t)k * T * 16; }

__device__ __forceinline__ void rstd_cache_fill(Frame& F, const pg8::StaticOrder& S, const float* ss) {
    LAS float* rc = (LAS float*)(F.lds + RSTD_CACHE_OFF);
    pg8::Unit u;
    for (int i = (F.tid >> 8); i < RSTD_CACHE_MAX && S.next(i, u); i += 2) rc[i * 256 + (F.tid & 255)] = row_rstd(ss, u.pm * 256 + (F.tid & 255));
    __syncthreads();
}

__device__ __forceinline__ int dst_row(int mode, int n) {
    if (mode == 1) { if (n < 1024) { const int d = n & 63; return (n & ~63) + ((d < 32) ? 2 * d : 2 * (d - 32) + 1); } return n; }
    if (mode == 2) return (n >> 7) * 256 + (n & 127);
    if (mode == 3) return (n >> 7) * 256 + 128 + (n & 127);
    return n;
}
struct TJob { const float* W; const float* gain; bf16* WT; int K, N, nblk, mode, item; float f8scale; int pitch; };
__device__ __forceinline__ bool p0_job(Frame& F, int it, TJob& J) {
    constexpr int I_IN = 16 * 48, I_OUT = 16 * 16, I_DG = 16 * 44, I_DD = 44 * 16, I_EG = 16 * 56, I_EDN = 56 * 16;
    constexpr int NITEMS = 2 * I_IN + 2 * I_OUT + 2 * I_DG + I_DD + NEXP * (2 * I_EG + I_EDN);
    if (it >= NITEMS) return false;
    int r = it;
    if (r < 2 * I_IN) { const int l = r / I_IN; r -= l * I_IN; J = TJob{F.in[I_WIN] + (size_t)l * DM * INTOT, F.in[I_MIXNORM] + l * DM, (bf16*)(F.ws + WS_WIN) + (size_t)l * NPROJ * DM, DM, INTOT, 48, 1, r, 0.f, 0}; return true; } r -= 2 * I_IN;
    if (r < 2 * I_OUT) { const int l = r / I_OUT; r -= l * I_OUT; J = TJob{F.in[I_WOUT] + (size_t)l * DM * DM, nullptr, (bf16*)(F.ws + WS_WOUT) + (size_t)l * DM * DM, DM, DM, 16, 0, r, 0.f, 0}; return true; } r -= 2 * I_OUT;
    if (r < I_DG) { J = TJob{F.in[I_DWG], F.in[I_FFNNORM], (bf16*)(F.ws + WS_WGU), DM, FFD, 44, 2, r, 0.f, 0}; return true; } r -= I_DG;
    if (r < I_DG) { J = TJob{F.in[I_DWU], F.in[I_FFNNORM], (bf16*)(F.ws + WS_WGU), DM, FFD, 44, 3, r, 0.f, 0}; return true; } r -= I_DG;
    if (r < I_DD) { J = TJob{F.in[I_DWD], nullptr, (bf16*)(F.ws + WS_WD), FFD, DM, 16, 0, r, 0.f, FFD_PITCH}; return true; } r -= I_DD;
    const int e = r / (2 * I_EG + I_EDN); r -= e * (2 * I_EG + I_EDN);
    if (r < I_EG) { J = TJob{F.in[I_EWG] + (size_t)e * DM * FFE, F.in[I_FFNNORM] + DM, (bf16*)(F.ws + WS_EGU + (size_t)e * 2 * FFE * DM), DM, FFE, 56, 2, r, W8_UP, 0}; return true; } r -= I_EG;
    if (r < I_EG) { J = TJob{F.in[I_EWU] + (size_t)e * DM * FFE, F.in[I_FFNNORM] + DM, (bf16*)(F.ws + WS_EGU + (size_t)e * 2 * FFE * DM), DM, FFE, 56, 3, r, W8_UP, 0}; return true; } r -= I_EG;
    J = TJob{F.in[I_EWD] + (size_t)e * FFE * DM, nullptr, (bf16*)(F.ws + WS_ED + (size_t)e * DM * FFE_PITCH), FFE, DM, 16, 0, r, W8_DN, FFE_PITCH}; return true;
}
__device__ __forceinline__ void t64_load(const TJob& J, int lane, f32x4 (&v)[16]) {
    const int kb = J.item / J.nblk, nb = J.item % J.nblk;
    const float* src = J.W + (size_t)(64 * kb + (lane >> 4)) * J.N + 64 * nb + 4 * (lane & 15);
#pragma unroll
    for (int i = 0; i < 16; ++i) v[i] = *(const f32x4*)(src + (size_t)(4 * i) * J.N);
}
__device__ __forceinline__ void t64_finish(const TJob& J, int lane, const f32x4 (&v)[16], LAS float* scr) {
    const int kb = J.item / J.nblk, nb = J.item % J.nblk, k0 = 64 * kb, n0 = 64 * nb;
#pragma unroll
    for (int i = 0; i < 16; ++i) { LAS float* d = scr + (4 * i + (lane >> 4)) * 65 + 4 * (lane & 15); d[0] = v[i][0]; d[1] = v[i][1]; d[2] = v[i][2]; d[3] = v[i][3]; }
    LDS_WAIT(); asm volatile("" ::: "memory");
    const int c = lane & 7;
    float g[8];
#pragma unroll
    for (int i = 0; i < 8; ++i) g[i] = J.gain ? J.gain[k0 + 8 * c + i] : 1.0f;
    if (J.f8scale != 0.f) {
#pragma unroll
        for (int i = 0; i < 8; ++i) g[i] *= J.f8scale;
        unsigned char* W8 = (unsigned char*)J.WT;
#pragma unroll
        for (int j = 0; j < 8; ++j) { const int n = (lane >> 3) + 8 * j; const LAS float* s = scr + (8 * c) * 65 + n;
            unsigned long long o = (unsigned long long)pg8::pk4_fp8(s[0 * 65] * g[0], s[1 * 65] * g[1], s[2 * 65] * g[2], s[3 * 65] * g[3]) | ((unsigned long long)pg8::pk4_fp8(s[4 * 65] * g[4], s[5 * 65] * g[5], s[6 * 65] * g[6], s[7 * 65] * g[7]) << 32);
            *(GAS unsigned long long*)(W8 + (size_t)dst_row(J.mode, n0 + n) * (J.pitch ? J.pitch : J.K) + k0 + 8 * c) = o; }
    } else {
#pragma unroll
    for (int j = 0; j < 8; ++j) { const int n = (lane >> 3) + 8 * j; const LAS float* s = scr + (8 * c) * 65 + n;
        v4u o; o.x = pk2(s[0 * 65] * g[0], s[1 * 65] * g[1]); o.y = pk2(s[2 * 65] * g[2], s[3 * 65] * g[3]); o.z = pk2(s[4 * 65] * g[4], s[5 * 65] * g[5]); o.w = pk2(s[6 * 65] * g[6], s[7 * 65] * g[7]);
        *(GAS v4u*)(J.WT + (size_t)dst_row(J.mode, n0 + n) * (J.pitch ? J.pitch : J.K) + k0 + 8 * c) = o; }
    }
    LDS_WAIT(); asm volatile("" ::: "memory");
}
__device__ __forceinline__ void p0_prologue(Frame& F) {
    LAS float* scr = (LAS float*)(F.lds + RING_OFF + F.wave * 16640);
    const int gw = F.vcu * NWAVES + F.wave, NGW = F.G * NWAVES, lane = F.lane;
    {
        TJob J, Jn; f32x4 v[16], vn[16];
        int it = gw; bool have = p0_job(F, it, J);
        if (have) t64_load(J, lane, v);
        while (have) {
            const bool hn = p0_job(F, it + NGW, Jn);
            if (hn) t64_load(Jn, lane, vn);
            t64_finish(J, lane, v, scr);
            if (!hn) break;
            J = Jn; it += NGW;
#pragma unroll
            for (int i = 0; i < 16; ++i) v[i] = vn[i];
        }
    }
    {
        float* ss0 = ss_arr(F, 0); bf16* HB = (bf16*)(F.ws + WS_HB);
        for (int m = gw; m < T; m += NGW) {
            const GAS f32x4* xr = (const GAS f32x4*)(F.in[I_X] + (size_t)m * DM) + lane;
            f32x4 v[4]; float s = 0.f;
#pragma unroll
            for (int j = 0; j < 4; ++j) { v[j] = xr[64 * j]; const unsigned p0_ = pk2(v[j].x, v[j].y), p1_ = pk2(v[j].z, v[j].w); const float a0 = bflo(p0_), a1 = bfhi(p0_), a2 = bflo(p1_), a3 = bfhi(p1_); s += (a0 * a0 + a1 * a1) + (a2 * a2 + a3 * a3); }
            s = wave_sum(s);
            GAS unsigned long long* o8 = (GAS unsigned long long*)(HB + (size_t)m * DM) + lane;
#pragma unroll
            for (int j = 0; j < 4; ++j) o8[64 * j] = (unsigned long long)pk2(v[j].x, v[j].y) | ((unsigned long long)pk2(v[j].z, v[j].w) << 32);
            if (lane < 16) ss0[(size_t)m * 16 + lane] = (lane == 0) ? s : 0.f;
        }
    }
    const int gt = F.vcu * (NWAVES * 64) + F.tid, NGT = F.G * NWAVES * 64;
    for (int i = gt; i < 2 * 16 * DM; i += NGT) { const int l = i / (16 * DM), r = (i / DM) & 15, k = i & (DM - 1);
        ((bf16*)(F.ws + WS_WGZ))[i] = (bf16)f2bf(F.in[I_WIN][(size_t)l * DM * INTOT + (size_t)k * INTOT + NPROJ + r] * F.in[I_MIXNORM][l * DM + k]); }
    for (int i = gt; i < 16 * DM; i += NGT) { const int e = i >> 10, k = i & (DM - 1); const float v = (e < NEXP) ? F.in[I_ROUTER][k * NEXP + e] * F.in[I_FFNNORM][DM + k] : 0.f;
        const unsigned hb_ = f2bf(v); const float vh = __uint_as_float(hb_ << 16); ((bf16*)(F.ws + WS_RG))[i] = (bf16)hb_; ((bf16*)(F.ws + WS_RG))[16 * DM + i] = (bf16)f2bf(v - vh); }
    for (int i = gt; i < SEQ * 32; i += NGT) { const int pos = i >> 5, fi = i & 31;
        const float inv = 1.0f / powf(10000.0f, (float)(2 * fi) / 64.0f);
        const float ang = (float)pos * inv;
        const double rev = (double)ang * 0.15915494309189535; const double fr = rev - rint(rev);
        const float f = (float)fr;
        float* o = (float*)(F.ws + WS_ROPE) + (size_t)i * 2; o[0] = __builtin_amdgcn_cosf(f); o[1] = __builtin_amdgcn_sinf(f); }
}

__device__ __forceinline__ void gz_phase(Frame& F, const bf16* HB, const bf16* WGZ, const float* ss, float* GZ) {
    const int gw = F.vcu * NWAVES + F.wave, NGW = F.G * NWAVES, lane = F.lane;
    for (int task = gw; task < T / 16; task += NGW) {
        const int t0 = task * 16;
        const bf16* ap = WGZ + (size_t)(lane & 15) * DM + 8 * (lane >> 4);
        const bf16* bp = HB + (size_t)(t0 + (lane & 15)) * DM + 8 * (lane >> 4);
        f32x4 acc = (f32x4){0.f, 0.f, 0.f, 0.f};
#pragma unroll 1
        for (int s0 = 0; s0 < 32; s0 += 16) {
            bf16x8 a[16], b[16];
#pragma unroll
            for (int q = 0; q < 16; ++q) { a[q] = *(const bf16x8*)(ap + 32 * (s0 + q)); b[q] = *(const bf16x8*)(bp + 32 * (s0 + q)); }
            asm volatile("" : "+v"(a[0]), "+v"(a[1]), "+v"(a[2]), "+v"(a[3]), "+v"(a[4]), "+v"(a[5]), "+v"(a[6]), "+v"(a[7]), "+v"(a[8]), "+v"(a[9]), "+v"(a[10]), "+v"(a[11]), "+v"(a[12]), "+v"(a[13]), "+v"(a[14]), "+v"(a[15]) :: "memory");
            asm volatile("" : "+v"(b[0]), "+v"(b[1]), "+v"(b[2]), "+v"(b[3]), "+v"(b[4]), "+v"(b[5]), "+v"(b[6]), "+v"(b[7]), "+v"(b[8]), "+v"(b[9]), "+v"(b[10]), "+v"(b[11]), "+v"(b[12]), "+v"(b[13]), "+v"(b[14]), "+v"(b[15]) :: "memory");
#pragma unroll
            for (int q = 0; q < 16; ++q) acc = __builtin_amdgcn_mfma_f32_16x16x32_bf16(a[q], b[q], acc, 0, 0, 0);
        }
        const int tok = t0 + (lane & 15);
        const float rstd = row_rstd(ss, tok);
        *(f32x4*)(GZ + (size_t)tok * 16 + 4 * (lane >> 4)) = acc * rstd;
    }
}

__device__ __forceinline__ void conv_phase(int gt, int NGT, const bf16* PROJ, const float* cw, bf16* MIX) {
    for (int i = gt; i < T * 32; i += NGT) {
        const int t = i >> 5, c0 = (i & 31) * 8, tp = t & (SEQ - 1);
        float y[8];
#pragma unroll
        for (int e = 0; e < 8; ++e) y[e] = 0.f;
#pragma unroll
        for (int j = 0; j < 3; ++j) { const int dt = 2 - j; if (tp - dt < 0) continue;
            const v4u cc = *(const v4u*)(PROJ + (size_t)(t - dt) * NPROJ + PC_CC + c0), ch = *(const v4u*)(PROJ + (size_t)(t - dt) * NPROJ + PC_CH + c0);
            const f32x4 w0 = *(const f32x4*)(cw + j * 256 + c0), w1 = *(const f32x4*)(cw + j * 256 + c0 + 4);
            y[0] += w0[0] * (bflo(cc.x) * bflo(ch.x)); y[1] += w0[1] * (bfhi(cc.x) * bfhi(ch.x)); y[2] += w0[2] * (bflo(cc.y) * bflo(ch.y)); y[3] += w0[3] * (bfhi(cc.y) * bfhi(ch.y));
            y[4] += w1[0] * (bflo(cc.z) * bflo(ch.z)); y[5] += w1[1] * (bfhi(cc.z) * bfhi(ch.z)); y[6] += w1[2] * (bflo(cc.w) * bflo(ch.w)); y[7] += w1[3] * (bfhi(cc.w) * bfhi(ch.w)); }
        const v4u cb = *(const v4u*)(PROJ + (size_t)t * NPROJ + PC_CB + c0);
        v4u o; o.x = pk2(y[0] * bflo(cb.x), y[1] * bfhi(cb.x)); o.y = pk2(y[2] * bflo(cb.y), y[3] * bfhi(cb.y)); o.z = pk2(y[4] * bflo(cb.z), y[5] * bfhi(cb.z)); o.w = pk2(y[6] * bflo(cb.w), y[7] * bfhi(cb.w));
        *(v4u*)(MIX + (size_t)t * DM + 512 + c0) = o;
    }
}

typedef float f32x16 __attribute__((ext_vector_type(16)));
typedef short v4i16_t __attribute__((ext_vector_type(4)));
constexpr int A2_KROW = 144, A2_VROW = 192, A2_ROWS = 384, A2_K_OFF = 0, A2_V_OFF = A2_ROWS * A2_KROW;
static_assert(A2_V_OFF + A2_ROWS * A2_VROW <= RING_BYTES, "attention LDS");
constexpr int A2_UNITS = 3 * NB * 8 * 32;
constexpr size_t WS_OPART = WS_DYN + 134 * MiB;
constexpr size_t WS_LSE = WS_DYN + 182 * MiB;
__device__ __forceinline__ bf16x8 pack8(float a0, float a1, float a2, float a3, float a4, float a5, float a6, float a7) {
    v4u w; w.x = pg8::cvt_pk_bf16(a0, a1); w.y = pg8::cvt_pk_bf16(a2, a3); w.z = pg8::cvt_pk_bf16(a4, a5); w.w = pg8::cvt_pk_bf16(a6, a7); return __builtin_bit_cast(bf16x8, w); }
__device__ __forceinline__ bf16x8 tr8(const LAS unsigned char* p0, const LAS unsigned char* p1) {
    const v4i16_t a = __builtin_amdgcn_ds_read_tr16_b64_v4i16((LAS v4i16_t*)p0), b = __builtin_amdgcn_ds_read_tr16_b64_v4i16((LAS v4i16_t*)p1);
    return (bf16x8){a[0], a[1], a[2], a[3], b[0], b[1], b[2], b[3]}; }
struct A2Unit { int dli, dl, b, h, r, P0, L; };
__device__ __forceinline__ void a2_decode(int unit, A2Unit& u) {
    u.dli = unit >> 9; const int rem = unit & 511; u.b = rem >> 8; u.h = (rem >> 5) & 7; const int j = rem & 31;
    u.dl = (u.dli == 0) ? 1 : (u.dli == 1) ? 4 : 16; const int sh = (u.dli == 0) ? 5 : (u.dli == 1) ? 3 : 1;
    u.r = j >> sh; u.P0 = (j & ((1 << sh) - 1)) * 256; u.L = SEQ / u.dl;
}
__device__ __forceinline__ void a2_issue(const bf16* PROJ, const A2Unit& u, int tid, int w, int lane, v4u (&kk)[6], v4u (&vv)[6], bf16x8 (&qf)[4]) {
#pragma unroll
    for (int i = 0; i < 6; ++i) { const int c = tid + 512 * i, row = c >> 3, c16 = c & 7; int p = u.P0 - 128 + row; p = p < 0 ? 0 : (p >= u.L ? u.L - 1 : p);
        const bf16* src = PROJ + (size_t)(u.b * SEQ + p * u.dl + u.r) * NPROJ + u.h * 64 + c16 * 8;
        kk[i] = *(const v4u*)(src + PC_K); vv[i] = *(const v4u*)(src + PC_V); }
    const int pq = u.P0 + 32 * w + (lane & 31);
    const bf16* qp = PROJ + (size_t)(u.b * SEQ + pq * u.dl + u.r) * NPROJ + PC_Q + u.h * 64 + 8 * (lane >> 5);
#pragma unroll
    for (int s = 0; s < 4; ++s) qf[s] = *(const bf16x8*)(qp + 16 * s);
}
__device__ __forceinline__ void a2_stage(LAS unsigned char* lds, int tid, const v4u (&kk)[6], const v4u (&vv)[6]) {
#pragma unroll
    for (int i = 0; i < 6; ++i) { const int c = tid + 512 * i, row = c >> 3, c16 = c & 7;
        *(LAS v4u*)(lds + A2_K_OFF + row * A2_KROW + c16 * 16) = kk[i]; *(LAS v4u*)(lds + A2_V_OFF + row * A2_VROW + c16 * 16) = vv[i]; }
}
__device__ __forceinline__ void a2_compute(const LAS unsigned char* lds, const A2Unit& u, int w, int lane, const bf16x8 (&qf)[4], bf16* OPART, float* LSE) {
    const int r32 = lane & 31, hi = lane >> 5;
    const int pq = u.P0 + 32 * w + r32;
    f32x16 o[2]; o[0] = (f32x16){}; o[1] = (f32x16){}; float m = -1e30f, l = 0.f;
    const LAS unsigned char* kb = lds + A2_K_OFF + (32 * w + r32) * A2_KROW + 16 * hi;
    const LAS unsigned char* trb = lds + A2_V_OFF + (32 * w + 4 * hi + ((lane & 15) >> 2)) * A2_VROW + (16 * ((lane >> 4) & 1) + 4 * (lane & 3)) * 2;
#pragma unroll
    for (int kt = 0; kt < 5; ++kt) {
        const int pkb = u.P0 - 128 + 32 * w + 32 * kt;
        if (pkb + 31 < 0) continue;
        f32x16 st = {};
#pragma unroll
        for (int s = 0; s < 4; ++s) { const bf16x8 kf = *(const LAS bf16x8*)(kb + kt * 32 * A2_KROW + 32 * s); st = __builtin_amdgcn_mfma_f32_32x32x16_bf16(kf, qf[s], st, 0, 0, 0); }
        float tmax = -1e30f;
        if (pkb < 0) {
#pragma unroll
            for (int r = 0; r < 16; ++r) { const int pk = pkb + (r & 3) + 8 * (r >> 2) + 4 * hi; const int df = pq - pk;
                const bool ok = pk >= 0 && df >= 0 && df <= 128; st[r] = ok ? st[r] : -1e30f; }
        } else if (kt == 0) {
            const int dd = r32 - 4 * hi;
#pragma unroll
            for (int r = 0; r < 16; ++r) st[r] = ((r & 3) + 8 * (r >> 2) >= dd) ? st[r] : -1e30f;
        } else if (kt == 4) {
            const int dd = r32 - 4 * hi;
#pragma unroll
            for (int r = 0; r < 16; ++r) st[r] = ((r & 3) + 8 * (r >> 2) <= dd) ? st[r] : -1e30f;
        }
#pragma unroll
        for (int r = 0; r < 16; ++r) tmax = fmaxf(tmax, st[r]);
        tmax = fmaxf(tmax, __shfl_xor(tmax, 32));
        const float mn = fmaxf(m, tmax), alpha = fast_exp2(m - mn); m = mn;
        float ps = 0.f;
#pragma unroll
        for (int r = 0; r < 16; ++r) { st[r] = fast_exp2(st[r] - mn); ps += st[r]; }
        l = l * alpha + ps;
        o[0] *= alpha; o[1] *= alpha;
        const bf16x8 p0 = pack8(st[0], st[1], st[2], st[3], st[4], st[5], st[6], st[7]), p1 = pack8(st[8], st[9], st[10], st[11], st[12], st[13], st[14], st[15]);
        const LAS unsigned char* tb = trb + kt * 32 * A2_VROW;
#pragma unroll
        for (int vt = 0; vt < 2; ++vt) {
            const bf16x8 a0 = tr8(tb + vt * 64, tb + vt * 64 + 8 * A2_VROW), a1 = tr8(tb + vt * 64 + 16 * A2_VROW, tb + vt * 64 + 24 * A2_VROW);
            o[vt] = __builtin_amdgcn_mfma_f32_32x32x16_bf16(a0, p0, o[vt], 0, 0, 0);
            o[vt] = __builtin_amdgcn_mfma_f32_32x32x16_bf16(a1, p1, o[vt], 0, 0, 0);
        }
    }
    const float lt = l + __shfl_xor(l, 32), rl = 1.0f / lt;
    const size_t tok = (size_t)u.b * SEQ + (size_t)pq * u.dl + u.r;
    bf16* op = OPART + ((size_t)u.dli * T + tok) * 512 + u.h * 64 + 4 * hi;
#pragma unroll
    for (int vt = 0; vt < 2; ++vt)
#pragma unroll
        for (int g = 0; g < 4; ++g) { const unsigned long long wv = (unsigned long long)pg8::cvt_pk_bf16(o[vt][4 * g] * rl, o[vt][4 * g + 1] * rl) | ((unsigned long long)pg8::cvt_pk_bf16(o[vt][4 * g + 2] * rl, o[vt][4 * g + 3] * rl) << 32);
            *(unsigned long long*)(op + 32 * vt + 8 * g) = wv; }
    if (hi == 0) LSE[((size_t)u.dli * T + tok) * 8 + u.h] = m + __builtin_amdgcn_logf(lt);
}
__device__ __forceinline__ void attn_phase(Frame& F, const bf16* PROJ) {
    LAS unsigned char* lds = F.lds + RING_OFF;
    bf16* OPART = (bf16*)(F.ws + WS_OPART); float* LSE = (float*)(F.ws + WS_LSE);
    const int lane = F.lane, w = F.wave, tid = F.tid;
    int unit = F.vcu;
    if (unit >= A2_UNITS) return;
    v4u kk[6], vv[6]; bf16x8 qn[4], qf[4]; A2Unit u, un;
    a2_decode(unit, u);
    a2_issue(PROJ, u, tid, w, lane, kk, vv, qn);
    __syncthreads();
    for (;;) {
        a2_stage(lds, tid, kk, vv);
#pragma unroll
        for (int s = 0; s < 4; ++s) qf[s] = qn[s];
        const int nxt = unit + F.G; const bool has_next = nxt < A2_UNITS;
        __syncthreads();
        if (has_next) { a2_decode(nxt, un); a2_issue(PROJ, un, tid, w, lane, kk, vv, qn); }
        a2_compute(lds, u, w, lane, qf, OPART, LSE);
        if (PROBE_REP == 777) a2_compute(lds, u, w, lane, qf, OPART, LSE);
        if (!has_next) break;
        __syncthreads();
        unit = nxt; u = un;
    }
    __syncthreads();
}
__device__ __forceinline__ void attn_merge(Frame& F, int gt, int NGT, bf16* MIX) {
    const bf16* OPART = (const bf16*)(F.ws + WS_OPART); const float* LSE = (const float*)(F.ws + WS_LSE);
    for (int i = gt; i < T * 64; i += NGT) {
        const int tok = i >> 6, c = i & 63, h = c >> 3;
        const float l0 = LSE[(size_t)tok * 8 + h], l1 = LSE[((size_t)T + tok) * 8 + h], l2 = LSE[((size_t)2 * T + tok) * 8 + h];
        const float M = fmaxf(l0, fmaxf(l1, l2)); float w0 = fast_exp2(l0 - M), w1 = fast_exp2(l1 - M), w2 = fast_exp2(l2 - M); const float rs = 1.0f / (w0 + w1 + w2); w0 *= rs; w1 *= rs; w2 *= rs;
        const v4u a = *(const v4u*)(OPART + (size_t)tok * 512 + c * 8), b = *(const v4u*)(OPART + ((size_t)T + tok) * 512 + c * 8), d = *(const v4u*)(OPART + ((size_t)2 * T + tok) * 512 + c * 8);
        v4u o;
        o.x = pk2(w0 * bflo(a.x) + w1 * bflo(b.x) + w2 * bflo(d.x), w0 * bfhi(a.x) + w1 * bfhi(b.x) + w2 * bfhi(d.x));
        o.y = pk2(w0 * bflo(a.y) + w1 * bflo(b.y) + w2 * bflo(d.y), w0 * bfhi(a.y) + w1 * bfhi(b.y) + w2 * bfhi(d.y));
        o.z = pk2(w0 * bflo(a.z) + w1 * bflo(b.z) + w2 * bflo(d.z), w0 * bfhi(a.z) + w1 * bfhi(b.z) + w2 * bfhi(d.z));
        o.w = pk2(w0 * bflo(a.w) + w1 * bflo(b.w) + w2 * bflo(d.w), w0 * bfhi(a.w) + w1 * bfhi(b.w) + w2 * bfhi(d.w));
        *(v4u*)(MIX + (size_t)tok * DM + c * 8) = o;
    }
}


constexpr int GLA_SEG = 4, GLA_NSEG = SEQ / (32 * GLA_SEG);
constexpr int GLA_AGG_STRIDE = 2048 + 32;
constexpr int GL_Q = 0, GL_K = 2048, GL_V = 4096, GL_EB = 4096 + 6144, GL_WAVE_BYTES = 10496;
static_assert(8 * GL_WAVE_BYTES <= RING_BYTES, "gla LDS");
constexpr size_t WS_GLAAGG = WS_DYN + 128 * MiB;
constexpr size_t WS_GLASST = WS_DYN + 184 * MiB;

struct GlaCtx { const bf16* PROJ; const float* GZ; const float* wglr; const float* bglr; const float* gnorm; bf16* MIX; float* AGG; const float* SST; };

__device__ __forceinline__ float gla_prep_chunk(const GlaCtx& C, int h, size_t row0, const float (&W)[8], float bias, LAS unsigned char* L, int lane) {
    const int kf = lane & 31, hi = lane >> 5;
    v4u vv[4];
#pragma unroll
    for (int i = 0; i < 4; ++i) vv[i] = *(const v4u*)(C.PROJ + (row0 + (lane >> 3) + 8 * i) * NPROJ + PC_GV + h * 64 + (lane & 7) * 8);
    f32x4 gr[4];
#pragma unroll
    for (int i = 0; i < 4; ++i) gr[i] = *(const f32x4*)(C.GZ + (row0 + kf) * 16 + 4 * i);
    v4u qraw[2], kraw[2];
#pragma unroll
    for (int i = 0; i < 2; ++i) { const int c = lane + 64 * i; const bf16* src = C.PROJ + (row0 + (c >> 2)) * NPROJ + h * 32 + (c & 3) * 8; qraw[i] = *(const v4u*)(src + PC_GQ); kraw[i] = *(const v4u*)(src + PC_GK); }
    asm volatile("" : "+v"(vv[0]), "+v"(vv[1]), "+v"(vv[2]), "+v"(vv[3]), "+v"(gr[0]), "+v"(gr[1]), "+v"(gr[2]), "+v"(gr[3]), "+v"(qraw[0]), "+v"(qraw[1]), "+v"(kraw[0]), "+v"(kraw[1]));
#pragma unroll
    for (int i = 0; i < 2; ++i) { const int c = lane + 64 * i; *(LAS v4u*)(L + GL_Q + (c >> 2) * 64 + (c & 3) * 16) = qraw[i]; *(LAS v4u*)(L + GL_K + (c >> 2) * 64 + (c & 3) * 16) = kraw[i]; }
#pragma unroll
    for (int i = 0; i < 4; ++i) *(LAS v4u*)(L + GL_V + ((lane >> 3) + 8 * i) * 192 + (lane & 7) * 16) = vv[i];
    f32x16 z = {};
#pragma unroll
    for (int s = 0; s < 8; ++s) { const float a = hi ? gr[s >> 1][2 * (s & 1) + 1] : gr[s >> 1][2 * (s & 1)]; z = __builtin_amdgcn_mfma_f32_32x32x2f32(a, W[s], z, 0, 0, 0); }
    float bc[16], sg[4];
#pragma unroll
    for (int g4 = 0; g4 < 4; ++g4) { float run = 0.f;
#pragma unroll
        for (int e = 0; e < 4; ++e) { const float zz = z[4 * g4 + e] + bias;
            const float ls = fminf(zz, 0.f) - 0.6931471805599453f * __builtin_amdgcn_logf(1.0f + fast_exp2(-fabsf(zz) * LOG2E));
            run += ls * (1.0f / 16.0f); bc[4 * g4 + e] = run; }
        sg[g4] = run; }
    float off = 0.f, tot;
#pragma unroll
    for (int g4 = 0; g4 < 4; ++g4) { const float pg = __shfl_xor(sg[g4], 32); const float o_here = off + (hi ? pg : 0.f);
#pragma unroll
        for (int e = 0; e < 4; ++e) bc[4 * g4 + e] += o_here;
        off += sg[g4] + pg; }
    tot = off;
    const float qscale = 0.17677669529663687f;
    asm volatile("s_waitcnt lgkmcnt(0)" ::: "memory");
#pragma unroll
    for (int r = 0; r < 16; ++r) { const int t = (r & 3) + 8 * (r >> 2) + 4 * hi; const float e = fast_exp2(bc[r] * LOG2E), ei = fast_exp2(-bc[r] * LOG2E);
        LAS unsigned short* qp = (LAS unsigned short*)(L + GL_Q + t * 64 + kf * 2); LAS unsigned short* kp = (LAS unsigned short*)(L + GL_K + t * 64 + kf * 2);
        *qp = (unsigned short)f2bf(bf2f(*qp) * qscale * e); *kp = (unsigned short)f2bf(bf2f(*kp) * ei); }
    if (hi == 0) *(LAS float*)(L + GL_EB + kf * 4) = fast_exp2(tot * LOG2E);
    asm volatile("s_waitcnt lgkmcnt(0)" ::: "memory");
    return tot;
}
__device__ __forceinline__ void gla_state_update(f32x16 (&S)[2], const LAS unsigned char* L, int lane) {
    const int hi = lane >> 5, q4 = (lane & 15) >> 2, cb = 16 * ((lane >> 4) & 1), p4 = 4 * (lane & 3);
#pragma unroll
    for (int st = 0; st < 2; ++st) {
        const LAS unsigned char* ka = L + GL_K + (16 * st + 8 * hi + q4) * 64 + (cb + p4) * 2;
        const bf16x8 a = tr8(ka, ka + 4 * 64);
#pragma unroll
        for (int vt = 0; vt < 2; ++vt) { const LAS unsigned char* vb = L + GL_V + (16 * st + 8 * hi + q4) * 192 + (32 * vt + cb + p4) * 2;
            const bf16x8 bfr = tr8(vb, vb + 4 * 192);
            S[vt] = __builtin_amdgcn_mfma_f32_32x32x16_bf16(a, bfr, S[vt], 0, 0, 0); }
    }
#pragma unroll
    for (int r = 0; r < 16; ++r) { const float e = *(const LAS float*)(L + GL_EB + ((r & 3) + 8 * (r >> 2) + 4 * hi) * 4); S[0][r] *= e; S[1][r] *= e; }
}
__device__ __forceinline__ void gla_load_w(const GlaCtx& C, int h, int lane, float (&W)[8], float& bias) {
    const int kf = lane & 31, hi = lane >> 5;
#pragma unroll
    for (int s = 0; s < 8; ++s) W[s] = C.wglr[(2 * s + hi) * 128 + h * 32 + kf];
    bias = C.bglr[h * 32 + kf];
}
__device__ __forceinline__ void gla_pass_a(const GlaCtx& C, int task, LAS unsigned char* L, int lane) {
    const int seg = task & (GLA_NSEG - 1), bh = task / GLA_NSEG, b = bh >> 2, h = bh & 3;
    float W[8], bias; gla_load_w(C, h, lane, W, bias);
    f32x16 S[2]; S[0] = (f32x16){}; S[1] = (f32x16){};
    float dtot = 0.f;
#pragma unroll 1
    for (int c = 0; c < GLA_SEG; ++c) {
        const size_t row0 = (size_t)b * SEQ + (size_t)(seg * GLA_SEG + c) * 32;
        dtot += gla_prep_chunk(C, h, row0, W, bias, L, lane);
        gla_state_update(S, L, lane);
        asm volatile("s_waitcnt lgkmcnt(0)" ::: "memory");
    }
    float* ag = C.AGG + (size_t)task * GLA_AGG_STRIDE;
#pragma unroll
    for (int vt = 0; vt < 2; ++vt)
#pragma unroll
        for (int r = 0; r < 16; ++r) ag[(vt * 16 + r) * 64 + lane] = S[vt][r];
    if (lane < 32) ag[2048 + lane] = dtot;
}
__device__ __forceinline__ void gla_pass_c(const GlaCtx& C, int task, LAS unsigned char* L, int lane) {
    const int seg = task & (GLA_NSEG - 1), bh = task / GLA_NSEG, b = bh >> 2, h = bh & 3;
    const int r32 = lane & 31, hi = lane >> 5;
    float W[8], bias; gla_load_w(C, h, lane, W, bias);
    f32x16 S[2]; S[0] = (f32x16){}; S[1] = (f32x16){};
    { const float* sst = C.SST + (size_t)task * 2048;
#pragma unroll
      for (int r = 0; r < 16; ++r) { S[0][r] = sst[r * 64 + lane]; S[1][r] = sst[(16 + r) * 64 + lane]; } }
#pragma unroll 1
    for (int c = 0; c < GLA_SEG; ++c) {
        const size_t row0 = (size_t)b * SEQ + (size_t)(seg * GLA_SEG + c) * 32;
        (void)gla_prep_chunk(C, h, row0, W, bias, L, lane);
        f32x16 at = {};
#pragma unroll
        for (int st = 0; st < 2; ++st) { const bf16x8 a = *(const LAS bf16x8*)(L + GL_K + r32 * 64 + (16 * st + 8 * hi) * 2), bq = *(const LAS bf16x8*)(L + GL_Q + r32 * 64 + (16 * st + 8 * hi) * 2);
            at = __builtin_amdgcn_mfma_f32_32x32x16_bf16(a, bq, at, 0, 0, 0); }
#pragma unroll
        for (int r = 0; r < 16; ++r) { const int s = (r & 3) + 8 * (r >> 2) + 4 * hi; at[r] = (s <= r32) ? at[r] : 0.f; }
        const bf16x8 pa0 = pack8(at[0], at[1], at[2], at[3], at[4], at[5], at[6], at[7]), pa1 = pack8(at[8], at[9], at[10], at[11], at[12], at[13], at[14], at[15]);
        f32x16 oT[2];
        const int q4 = (lane & 15) >> 2, cb = 16 * ((lane >> 4) & 1), p4 = 4 * (lane & 3);
#pragma unroll
        for (int vt = 0; vt < 2; ++vt) {
            const LAS unsigned char* vb = L + GL_V + (4 * hi + q4) * 192 + (32 * vt + cb + p4) * 2;
            const bf16x8 a0 = tr8(vb, vb + 8 * 192), a1 = tr8(vb + 16 * 192, vb + 24 * 192);
            f32x16 acc = {};
            acc = __builtin_amdgcn_mfma_f32_32x32x16_bf16(a0, pa0, acc, 0, 0, 0);
            acc = __builtin_amdgcn_mfma_f32_32x32x16_bf16(a1, pa1, acc, 0, 0, 0);
#pragma unroll
            for (int st = 0; st < 2; ++st) {
                const bf16x8 sa = pack8(S[vt][8 * st], S[vt][8 * st + 1], S[vt][8 * st + 2], S[vt][8 * st + 3], S[vt][8 * st + 4], S[vt][8 * st + 5], S[vt][8 * st + 6], S[vt][8 * st + 7]);
                const LAS unsigned char* qb = L + GL_Q + r32 * 64 + (16 * st + 4 * hi) * 2;
                const unsigned long long lo = *(const LAS unsigned long long*)qb, hh = *(const LAS unsigned long long*)(qb + 16);
                v4u w; w.x = (unsigned)lo; w.y = (unsigned)(lo >> 32); w.z = (unsigned)hh; w.w = (unsigned)(hh >> 32);
                acc = __builtin_amdgcn_mfma_f32_32x32x16_bf16(sa, __builtin_bit_cast(bf16x8, w), acc, 0, 0, 0);
            }
            oT[vt] = acc;
        }
        gla_state_update(S, L, lane);
        float ssq = 0.f;
#pragma unroll
        for (int r = 0; r < 16; ++r) ssq += oT[0][r] * oT[0][r] + oT[1][r] * oT[1][r];
        ssq += __shfl_xor(ssq, 32);
        const float rn = 1.0f / sqrtf(ssq * (1.0f / 64.0f) + EPS);
        const size_t row = row0 + r32;
        unsigned long long gwv[8]; f32x4 gnv[8];
#pragma unroll
        for (int q8 = 0; q8 < 8; ++q8) { const int v0 = 32 * (q8 >> 2) + 8 * (q8 & 3) + 4 * hi; gwv[q8] = *(const unsigned long long*)(C.PROJ + row * NPROJ + PC_GO + h * 64 + v0); gnv[q8] = *(const f32x4*)(C.gnorm + h * 64 + v0); }
        asm volatile("" : "+v"(gwv[0]), "+v"(gwv[1]), "+v"(gwv[2]), "+v"(gwv[3]), "+v"(gwv[4]), "+v"(gwv[5]), "+v"(gwv[6]), "+v"(gwv[7]), "+v"(gnv[0]), "+v"(gnv[1]), "+v"(gnv[2]), "+v"(gnv[3]), "+v"(gnv[4]), "+v"(gnv[5]), "+v"(gnv[6]), "+v"(gnv[7]));
#pragma unroll
        for (int vt = 0; vt < 2; ++vt)
#pragma unroll
            for (int g = 0; g < 4; ++g) { const int v0 = 32 * vt + 8 * g + 4 * hi;
                const unsigned long long gw = gwv[vt * 4 + g];
                const f32x4 gn = gnv[vt * 4 + g];
                const float g0 = bflo((unsigned)gw), g1 = bfhi((unsigned)gw), g2 = bflo((unsigned)(gw >> 32)), g3 = bfhi((unsigned)(gw >> 32));
                const float o0 = oT[vt][4 * g] * rn * gn[0] * (g0 * sigmoidf_(g0)), o1 = oT[vt][4 * g + 1] * rn * gn[1] * (g1 * sigmoidf_(g1));
                const float o2 = oT[vt][4 * g + 2] * rn * gn[2] * (g2 * sigmoidf_(g2)), o3 = oT[vt][4 * g + 3] * rn * gn[3] * (g3 * sigmoidf_(g3));
                *(unsigned long long*)(C.MIX + row * DM + 768 + h * 64 + v0) = (unsigned long long)pg8::cvt_pk_bf16(o0, o1) | ((unsigned long long)pg8::cvt_pk_bf16(o2, o3) << 32); }
        asm volatile("s_waitcnt lgkmcnt(0)" ::: "memory");
    }
}
__device__ __forceinline__ void gla_phase(Frame& F, int layer, bool passC) {
    GlaCtx C{(const bf16*)(F.ws + WS_PROJ), (const float*)(F.ws + WS_GZ), F.in[I_WGLR] + layer * 16 * 128, F.in[I_BGLR] + layer * 128, F.in[I_GLANORM] + layer * 256, (bf16*)(F.ws + WS_MIX), (float*)(F.ws + WS_GLAAGG), (const float*)(F.ws + WS_GLASST)};
    LAS unsigned char* L = F.lds + RING_OFF + F.wave * GL_WAVE_BYTES;
    for (int task = F.wave * F.G + F.vcu; task < NB * 4 * GLA_NSEG; task += NWAVES * F.G) {
        if (passC) gla_pass_c(C, task, L, F.lane); else gla_pass_a(C, task, L, F.lane);
    }
}

__device__ __forceinline__ void gla_scan(Frame& F) {
    const float* AGG = (const float*)(F.ws + WS_GLAAGG); float* SST = (float*)(F.ws + WS_GLASST);
    if (F.wave != 0) return;
    for (int eg = F.vcu * 64 + F.lane; eg < NB * 4 * 2048; eg += F.G * 64) {
        const int bh = eg >> 11, e = eg & 2047, r = (e >> 6) & 15, ln = e & 63, k = (r & 3) + 8 * (r >> 2) + 4 * (ln >> 5);
        const float* ag = AGG + (size_t)bh * GLA_NSEG * GLA_AGG_STRIDE; float* st = SST + (size_t)bh * GLA_NSEG * 2048 + e;
        float S = 0.f;
#pragma unroll 1
        for (int j0 = 0; j0 < GLA_NSEG; j0 += 16) {
            float dv[16], ev[16];
#pragma unroll
            for (int j = 0; j < 16; ++j) { dv[j] = ag[(size_t)(j0 + j) * GLA_AGG_STRIDE + 2048 + k]; ev[j] = ag[(size_t)(j0 + j) * GLA_AGG_STRIDE + e]; }
            asm volatile("" : "+v"(dv[0]), "+v"(dv[1]), "+v"(dv[2]), "+v"(dv[3]), "+v"(dv[4]), "+v"(dv[5]), "+v"(dv[6]), "+v"(dv[7]), "+v"(dv[8]), "+v"(dv[9]), "+v"(dv[10]), "+v"(dv[11]), "+v"(dv[12]), "+v"(dv[13]), "+v"(dv[14]), "+v"(dv[15]),
                         "+v"(ev[0]), "+v"(ev[1]), "+v"(ev[2]), "+v"(ev[3]), "+v"(ev[4]), "+v"(ev[5]), "+v"(ev[6]), "+v"(ev[7]), "+v"(ev[8]), "+v"(ev[9]), "+v"(ev[10]), "+v"(ev[11]), "+v"(ev[12]), "+v"(ev[13]), "+v"(ev[14]), "+v"(ev[15]));
#pragma unroll
            for (int j = 0; j < 16; ++j) { st[(size_t)(j0 + j) * 2048] = S; S = S * fast_exp2(dv[j] * LOG2E) + ev[j]; }
        }
    }
}

__device__ __forceinline__ void router_phase(Frame& F) {
    const bf16* H = (const bf16*)(F.ws + WS_HB); const float* ss = ss_arr(F, 3); const bf16* RG = (const bf16*)(F.ws + WS_RG);
    int* TOKE = (int*)(F.ws + WS_TOKE); float* TOKW = (float*)(F.ws + WS_TOKW); int* BLKCNT = (int*)(F.ws + WS_BLKCNT);
    LAS int* lcnt = (LAS int*)(F.lds + RING_OFF);
    const int lane = F.lane;
    for (int grp = blockIdx.x; grp < T / 64; grp += F.G) {
        if (F.tid < 8) lcnt[F.tid] = 0;
        __syncthreads();
        if (F.wave < 4) {
            const int t0 = grp * 64 + F.wave * 16;
            const bf16* ah = RG + (size_t)(lane & 15) * DM + 8 * (lane >> 4); const bf16* al = ah + 16 * DM;
            const bf16* bp = H + (size_t)(t0 + (lane & 15)) * DM + 8 * (lane >> 4);
            f32x4 acc = (f32x4){0.f, 0.f, 0.f, 0.f};
#pragma unroll 1
            for (int s0 = 0; s0 < 32; s0 += 8) {
                bf16x8 a[8], a2[8], bv[8];
#pragma unroll
                for (int j = 0; j < 8; ++j) { a[j] = *(const bf16x8*)(ah + 32 * (s0 + j)); a2[j] = *(const bf16x8*)(al + 32 * (s0 + j)); bv[j] = *(const bf16x8*)(bp + 32 * (s0 + j)); }
                asm volatile("" : "+v"(a[0]), "+v"(a[1]), "+v"(a[2]), "+v"(a[3]), "+v"(a[4]), "+v"(a[5]), "+v"(a[6]), "+v"(a[7]), "+v"(a2[0]), "+v"(a2[1]), "+v"(a2[2]), "+v"(a2[3]), "+v"(a2[4]), "+v"(a2[5]), "+v"(a2[6]), "+v"(a2[7]),
                             "+v"(bv[0]), "+v"(bv[1]), "+v"(bv[2]), "+v"(bv[3]), "+v"(bv[4]), "+v"(bv[5]), "+v"(bv[6]), "+v"(bv[7]));
#pragma unroll
                for (int j = 0; j < 8; ++j) { acc = __builtin_amdgcn_mfma_f32_16x16x32_bf16(a[j], bv[j], acc, 0, 0, 0); acc = __builtin_amdgcn_mfma_f32_16x16x32_bf16(a2[j], bv[j], acc, 0, 0, 0); }
            }
            float lg[8];
#pragma unroll
            for (int r = 0; r < 4; ++r) { lg[r] = acc[r]; lg[4 + r] = __shfl(acc[r], (lane & 15) + 16); }
            const int t = t0 + (lane & 15);
            const float rstd = row_rstd(ss, t);
            float l0 = -3.0e38f, l1 = -3.0e38f; int i0 = 0, i1 = 0;
#pragma unroll
            for (int e = 0; e < 8; ++e) { const float v = lg[e] * rstd; if (v > l0) { l1 = l0; i1 = i0; l0 = v; i0 = e; } else if (v > l1) { l1 = v; i1 = e; } }
            const float ex = expf(l1 - l0), w0 = 1.0f / (1.0f + ex), w1 = ex * w0;
            if (lane < 16) { TOKE[2 * t] = i0; TOKE[2 * t + 1] = i1; TOKW[2 * t] = w0; TOKW[2 * t + 1] = w1; atomicAdd((int*)&lcnt[i0], 1); atomicAdd((int*)&lcnt[i1], 1); }
        }
        __syncthreads();
        if (F.tid < 8) BLKCNT[grp * 8 + F.tid] = lcnt[F.tid];
        __syncthreads();
    }
}
__device__ __forceinline__ void dispatch_phase(Frame& F) {
    const int* BLKCNT = (const int*)(F.ws + WS_BLKCNT); const int* TOKE = (const int*)(F.ws + WS_TOKE); int* TOKS = (int*)(F.ws + WS_TOKS);
    float* SRSTD = (float*)(F.ws + WS_SRSTD); int* PANEL = (int*)(F.ws + WS_PANEL); const float* ss = ss_arr(F, 3);
    const bf16* HB = (const bf16*)(F.ws + WS_HB); unsigned char* ASORT = F.ws + WS_ASORT;
    LAS int* L = (LAS int*)(F.lds + RING_OFF);
    for (int grp = blockIdx.x; grp < T / 64; grp += F.G) {
        for (int i = F.tid; i < 2048; i += NWAVES * 64) L[i] = BLKCNT[i];
        __syncthreads();
        if (F.tid < 8) { int tot = 0, pre = 0; for (int g = 0; g < 256; ++g) { const int c = L[g * 8 + F.tid]; tot += c; if (g < grp) pre += c; } L[2048 + F.tid] = tot; L[2056 + F.tid] = pre; }
        __syncthreads();
        if (F.tid == 0) { int base = 0; for (int e = 0; e < 8; ++e) { L[2064 + e] = base; const int np = (L[2048 + e] + 255) >> 8;
                if (grp == 0) for (int p = 0; p < np; ++p) PANEL[8 + (base >> 8) + p] = e;
                base += np << 8; }
            if (grp == 0) PANEL[0] = base >> 8; }
        if (F.tid < 128) L[2080 + F.tid] = TOKE[(grp * 64) * 2 + F.tid];
        __syncthreads();
        if (F.tid < 128) { const int a = F.tid, e = L[2080 + a]; int rank = 0; for (int a2 = 0; a2 < a; ++a2) rank += (L[2080 + a2] == e) ? 1 : 0;
            const int slot = L[2064 + e] + L[2056 + e] + rank; const int t = grp * 64 + (a >> 1);
            TOKS[2 * t + (a & 1)] = slot; SRSTD[slot] = row_rstd(ss, t); L[2208 + a] = slot; }
        if (grp == 0) { for (int e = 0; e < 8; ++e) { const int b0 = L[2064 + e] + L[2048 + e], b1 = L[2064 + e] + (((L[2048 + e] + 255) >> 8) << 8); for (int s = b0 + F.tid; s < b1; s += NWAVES * 64) SRSTD[s] = 0.f; } }
        __syncthreads();
#pragma unroll
        for (int hb2 = 0; hb2 < 2; ++hb2) { v4u rv[8][2];
#pragma unroll
            for (int i = 0; i < 8; ++i) { const int a = F.wave + NWAVES * (8 * hb2 + i); const v4u* src = (const v4u*)(HB + (size_t)(grp * 64 + (a >> 1)) * DM); rv[i][0] = src[2 * F.lane]; rv[i][1] = src[2 * F.lane + 1]; }
#pragma unroll
            for (int i = 0; i < 8; ++i) { const int a = F.wave + NWAVES * (8 * hb2 + i); v4u* dst = (v4u*)(ASORT + (size_t)L[2208 + a] * DM);
                v4u o; o.x = pg8::pk4_fp8(bflo(rv[i][0].x), bfhi(rv[i][0].x), bflo(rv[i][0].y), bfhi(rv[i][0].y)); o.y = pg8::pk4_fp8(bflo(rv[i][0].z), bfhi(rv[i][0].z), bflo(rv[i][0].w), bfhi(rv[i][0].w));
                o.z = pg8::pk4_fp8(bflo(rv[i][1].x), bfhi(rv[i][1].x), bflo(rv[i][1].y), bfhi(rv[i][1].y)); o.w = pg8::pk4_fp8(bflo(rv[i][1].z), bfhi(rv[i][1].z), bflo(rv[i][1].w), bfhi(rv[i][1].w));
                dst[F.lane] = o; } }
        __syncthreads();
    }
}
__device__ __forceinline__ void final_phase(Frame& F) {
    const int lane = F.lane, wv = F.wave;
    const int gw = F.vcu * NWAVES + wv, NGW = F.G * NWAVES;
    const int* TOKS = (const int*)(F.ws + WS_TOKS); const float* TOKW = (const float*)(F.ws + WS_TOKW); const bf16* Y = (const bf16*)(F.ws + WS_Y);
    const float* fn = F.in[I_FINALNORM];
    for (int t = gw; t < T; t += NGW) {
        const int s0 = TOKS[2 * t], s1 = TOKS[2 * t + 1]; const float w0 = TOKW[2 * t], w1 = TOKW[2 * t + 1];
        GAS f32x4* xr = (GAS f32x4*)(F.out + (size_t)t * DM) + lane;
        const GAS unsigned long long* hr = (const GAS unsigned long long*)((const bf16*)(F.ws + WS_HB) + (size_t)t * DM) + lane;
        const GAS unsigned long long* y0 = (const GAS unsigned long long*)(Y + (size_t)s0 * DM) + lane; const GAS unsigned long long* y1 = (const GAS unsigned long long*)(Y + (size_t)s1 * DM) + lane;
        f32x4 v[4]; float s = 0.f;
#pragma unroll
        for (int j = 0; j < 4; ++j) { const unsigned long long hw = hr[64 * j], a = y0[64 * j], b = y1[64 * j];
            v[j].x = bflo((unsigned)hw) + w0 * bflo((unsigned)a) + w1 * bflo((unsigned)b); v[j].y = bfhi((unsigned)hw) + w0 * bfhi((unsigned)a) + w1 * bfhi((unsigned)b);
            v[j].z = bflo((unsigned)(hw >> 32)) + w0 * bflo((unsigned)(a >> 32)) + w1 * bflo((unsigned)(b >> 32)); v[j].w = bfhi((unsigned)(hw >> 32)) + w0 * bfhi((unsigned)(a >> 32)) + w1 * bfhi((unsigned)(b >> 32));
            s += (v[j].x * v[j].x + v[j].y * v[j].y) + (v[j].z * v[j].z + v[j].w * v[j].w); }
        s = wave_sum(s);
        const float rstd = 1.0f / sqrtf(s * (1.0f / DM) + EPS);
#pragma unroll
        for (int j = 0; j < 4; ++j) { const f32x4 g = *((const f32x4*)fn + lane + 64 * j); xr[64 * j] = v[j] * rstd * g; }
    }
}

__device__ __forceinline__ int fresh(Frame& F) { int l_; asm volatile("v_mbcnt_lo_u32_b32 %0, -1, 0\n\tv_mbcnt_hi_u32_b32 %0, -1, %0" : "=v"(l_)); F.lane = l_; F.tid = F.wave * 64 + l_; return 0; }
struct Args { const float* in[17]; float* out; unsigned char* ws; int ph_lo, ph_hi; };
constexpr int N_PHASES = 20;
#ifndef SK_UP
#define SK_UP 0
#endif

#ifndef MK_ONE_LAUNCH
#define MK_ONE_LAUNCH 1
#endif

__global__ void __launch_bounds__(NWAVES * 64, 2) mega_fwd(Args args) {
    extern __shared__ __attribute__((aligned(16))) unsigned char lds[];
    Frame F;
    F.lds = (LAS unsigned char*)lds;
    F.MISC = (volatile LAS unsigned*)(F.lds + MISC_OFF);
    F.tid = threadIdx.x; F.lane = F.tid & 63; F.wave = __builtin_amdgcn_readfirstlane(F.tid >> 6);
    F.G = gridDim.x; { const int bx = blockIdx.x; F.vcu = (F.G % 8 == 0) ? (bx % 8) * (F.G / 8) + bx / 8 : bx; }
    F.ws = args.ws; F.ctl = (gu32*)(args.ws + WS_CTL); F.out = args.out;
#pragma unroll
    for (int i = 0; i < 17; ++i) F.in[i] = args.in[i];
    for (int u = F.tid; u < (LDS_BYTES - LDSCTL_OFF) / 4; u += NWAVES * 64) ((LAS unsigned*)(F.lds + LDSCTL_OFF))[u] = 0u;
    __syncthreads();
    XcdBarrier bar; bar.bar = (unsigned*)(F.ctl + CW_BAR); bar.x = 0; bar.st = nullptr;
    if (MK_ONE_LAUNCH) bar = xcd_barrier_post((unsigned*)(F.ctl + CW_BAR), F.MISC + 8);
    const int lo = args.ph_lo, hi = args.ph_hi;
#define TS(id) do { if (PROBE_T == (id) && blockIdx.x == 0 && F.wave == ((PROBE_T >= 1000) ? 2 : 0)) { const unsigned t_ = (unsigned)__builtin_amdgcn_s_memrealtime(); ((volatile LAS unsigned*)(F.lds + LDSCTL_OFF))[16] = t_; } } while (0)
#define TE(id) do { if (PROBE_T == (id) && blockIdx.x == 0 && F.wave == ((PROBE_T >= 1000) ? 2 : 0)) { volatile LAS unsigned* w_ = (volatile LAS unsigned*)(F.lds + LDSCTL_OFF); const unsigned t_ = (unsigned)__builtin_amdgcn_s_memrealtime(); w_[17] = w_[17] + (t_ - w_[16]); } } while (0)
#define IN(k) (lo <= (k) && (k) < hi)
#define REPS(k) for (int rep_ = fresh(F); rep_ < ((PROBE_REP == (k)) ? 2 : 1); ++rep_, ((PROBE_REP == (k)) && rep_ < 2 ? (fresh(F), xcd_barrier(bar, F.tid == 0)) : (void)0))
#define SEAM(k) do { if (IN(k) && IN((k) + 1)) { fresh(F); xcd_barrier(bar, F.tid == 0); } TE(k); TS((k) + 1); } while (0)

    bf16* HB = (bf16*)(F.ws + WS_HB); bf16* PROJ = (bf16*)(F.ws + WS_PROJ); bf16* MIX = (bf16*)(F.ws + WS_MIX);

    TS(0);
    if (IN(0)) { REPS(0) p0_prologue(F); } SEAM(0);

#define MIXER_LAYER(l, pb) do { \
        if (IN(pb)) REPS(pb) { \
            pg8::Gemm g{HB, (const bf16*)(F.ws + WS_WIN) + (size_t)(l) * NPROJ * DM, T, NPROJ, DM}; pg8::StaticOrder S; S.init(T, NPROJ, F.G, (int)blockIdx.x); TS(140 + (pb)); rstd_cache_fill(F, S, ss_arr(F, 2 * (l))); TE(140 + (pb)); TS(150 + (pb)); \
            pg8::EpiProj E{PROJ, (const LAS float*)(F.lds + RSTD_CACHE_OFF), (const float*)(F.ws + WS_ROPE)}; \
            pg8::gemm_phase<pg8::EpiProj, pg8::StaticOrder, true, true>(F.lds + RING_OFF, g, S, E); TE(150 + (pb)); TS(160 + (pb)); \
            gz_phase(F, HB, (const bf16*)(F.ws + WS_WGZ) + (size_t)(l) * 16 * DM, ss_arr(F, 2 * (l)), (float*)(F.ws + WS_GZ)); TE(160 + (pb)); \
        } \
        SEAM(pb); \
        if (IN(pb + 1)) REPS(pb + 1) { TS(110 + (pb)); if (F.wave >= 2) conv_phase(F.vcu * 384 + F.tid - 128, F.G * 384, PROJ, F.in[I_CONVW] + (l) * 3 * 256, MIX); \
            for (int r2_ = 0; r2_ < ((PROBE_REP == 100 + (pb)) ? 2 : 1); ++r2_) gla_phase(F, (l), false); TE(110 + (pb)); TS(120 + (pb)); \
            for (int r3_ = 0; r3_ < ((PROBE_REP == 200 + (pb)) ? 2 : 1); ++r3_) attn_phase(F, PROJ); TE(120 + (pb)); } \
        SEAM(pb + 1); \
        if (IN(pb + 2)) REPS(pb + 2) { gla_scan(F); } \
        SEAM(pb + 2); \
        if (IN(pb + 3)) REPS(pb + 3) { TS(130 + (pb)); TS(1000 + (pb)); if (F.wave < 2) gla_phase(F, (l), true); else attn_merge(F, F.vcu * 384 + F.tid - 128, F.G * 384, MIX); TE(130 + (pb)); TE(1000 + (pb)); } \
        SEAM(pb + 3); \
        if (IN(pb + 4)) { fresh(F); \
            pg8::Gemm g{MIX, (const bf16*)(F.ws + WS_WOUT) + (size_t)(l) * DM * DM, T, DM, DM}; pg8::StaticOrder S; S.init(T, DM, F.G, (int)blockIdx.x); \
            pg8::EpiResid E{HB, ss_arr(F, 2 * (l) + 1)}; \
            pg8::gemm_phase<pg8::EpiResid, pg8::StaticOrder, true, true>(F.lds + RING_OFF, g, S, E); \
        } \
        SEAM(pb + 4); } while (0)

    MIXER_LAYER(0, 1);
    if (IN(6)) REPS(6) {
        pg8::Gemm g{HB, (const bf16*)(F.ws + WS_WGU), T, 2 * FFD, DM};
        if (SK_UP) { LAS int* sktab = (LAS int*)(F.lds + pg8::SK_TAB_OFF);
            pg8::sk_build(sktab, pg8::DenseMap{T / 256, 2 * FFD / 256}, (T / 256) * (2 * FFD / 256), DM / 128, F.G, (int)blockIdx.x, (float*)(F.ws + WS_SKP_FFN), (float*)(F.ws + WS_SKP_FFN), 1 << 20, (unsigned*)(F.ctl + CW_SKF), F.tid == 0);
            pg8::TabOrder S(sktab); pg8::EpiSK<pg8::EpiSwiglu> E{pg8::EpiSwiglu{(bf16*)(F.ws + WS_ACT), FFD_PITCH, nullptr, nullptr, 0, 22}, S.taddr, (unsigned*)(F.ctl + CW_TMO)};
            pg8::gemm_phase<pg8::EpiSK<pg8::EpiSwiglu>, pg8::TabOrder, true, true>(F.lds + RING_OFF, g, S, E);
        } else { pg8::StaticOrder S; S.init(T, 2 * FFD, F.G, (int)blockIdx.x); rstd_cache_fill(F, S, ss_arr(F, 1)); pg8::EpiSwiglu E{(bf16*)(F.ws + WS_ACT), FFD_PITCH, (const LAS float*)(F.lds + RSTD_CACHE_OFF), nullptr, 0, 22};
            pg8::gemm_phase<pg8::EpiSwiglu, pg8::StaticOrder, true, true>(F.lds + RING_OFF, g, S, E); }
    }
    SEAM(6);
    if (IN(7)) {
        fresh(F);
        pg8::Gemm g{(const bf16*)(F.ws + WS_ACT), (const bf16*)(F.ws + WS_WD), T, DM, FFD}; pg8::StaticOrder S; S.init(T, DM, F.G, (int)blockIdx.x);
        pg8::EpiResid E{HB, ss_arr(F, 2)};
        pg8::gemm_phase<pg8::EpiResid, pg8::StaticOrder, true, true, FFD_PITCH>(F.lds + RING_OFF, g, S, E);
    }
    SEAM(7);
    MIXER_LAYER(1, 8);
    if (IN(13)) REPS(13) { router_phase(F); } SEAM(13);
    if (IN(14)) REPS(14) { dispatch_phase(F); } SEAM(14);
    {
        const int* PANEL = (const int*)(F.ws + WS_PANEL); LAS int* sktab = (LAS int*)(F.lds + pg8::SK_TAB_OFF);
        if (IN(15)) REPS(15) {
            const int np = PANEL[0];
            pg8::sk_build(sktab, pg8::MoeMap{np, 28, 0, PANEL + 8}, np * 28, 0, F.G, (int)blockIdx.x, F.out, F.out, 1 << 20, (unsigned*)(F.ctl + CW_SKF), F.tid == 0);
            pg8::Gemm g{(const bf16*)(F.ws + WS_ASORT), (const bf16*)(F.ws + WS_EGU), 0, 0, DM}; pg8::TabOrder S(sktab);
            pg8::EpiSwiglu8 E{F.ws + WS_EACT, FFE_PITCH, (const float*)(F.ws + WS_SRSTD), 0, 28};
            pg8::gemm_phase8<pg8::EpiSwiglu8, pg8::TabOrder, true, true>(F.lds + RING_OFF, g, S, E, F.wave);
        }
        SEAM(15);
        if (IN(16)) REPS(16) {
            const int np = PANEL[0];
            pg8::sk_build(sktab, pg8::MoeMap{np, 4, 0, PANEL + 8}, np * 4, 0, F.G, (int)blockIdx.x, F.out, F.out, 1 << 20, (unsigned*)(F.ctl + CW_SKF + 4096), F.tid == 0);
            pg8::Gemm g{(const bf16*)(F.ws + WS_EACT), (const bf16*)(F.ws + WS_ED), 0, 0, FFE}; pg8::TabOrder S(sktab);
            pg8::EpiMoeDown E{(bf16*)(F.ws + WS_Y), 1.0f / W8_DN};
            pg8::gemm_phase8<pg8::EpiMoeDown, pg8::TabOrder, true, true, FFE_PITCH>(F.lds + RING_OFF, g, S, E, F.wave);
        }
        SEAM(18); TE(16);
    }
    if (IN(19)) { fresh(F); final_phase(F); }
    TE(19);
    if (PROBE_T != -1 && blockIdx.x == 0) { __syncthreads(); if (F.wave == 0) { const unsigned acc_ = ((volatile LAS unsigned*)(F.lds + LDSCTL_OFF))[17]; const unsigned long long t0_ = __builtin_amdgcn_s_memrealtime(); while (__builtin_amdgcn_s_memrealtime() - t0_ < 8ull * acc_) __builtin_amdgcn_s_sleep(8); } }
#undef IN
#undef SEAM
}

extern "C" void kernel_launch(void* const* d_in, const int* in_sizes, int n_in, void* d_out, int out_size, void* d_ws, size_t ws_size, hipStream_t stream) {
    static int grid = 0;
    if (grid == 0) {
        if (n_in != 17 || out_size != T * DM || ws_size < WS_END) { fprintf(stderr, "kernel_launch: unexpected shapes (n_in %d, out %d, ws %zu)\n", n_in, out_size, ws_size); grid = -1; return; }
        int dev = 0, cus = 0;
        if (hipGetDevice(&dev) != hipSuccess || hipDeviceGetAttribute(&cus, hipDeviceAttributeMultiprocessorCount, dev) != hipSuccess) { grid = -1; return; }
        if (hipFuncSetAttribute((const void*)mega_fwd, hipFuncAttributeMaxDynamicSharedMemorySize, LDS_BYTES) != hipSuccess) { grid = -1; return; }
        (void)hipGetLastError();
        grid = cus;
    }
    if (grid < 0) return;
    (void)hipMemsetAsync((char*)d_ws + WS_CTL, 0, CTL_ZERO_BYTES, stream);
    Args a{};
    for (int i = 0; i < 17; ++i) a.in[i] = (const float*)d_in[i];
    a.out = (float*)d_out; a.ws = (unsigned char*)d_ws;
#if MK_ONE_LAUNCH
    a.ph_lo = 0; a.ph_hi = N_PHASES;
    hipLaunchKernelGGL(mega_fwd, dim3(grid), dim3(NWAVES * 64), LDS_BYTES, stream, a);
#else
    for (int p = 0; p < N_PHASES; ++p) {
        a.ph_lo = p; a.ph_hi = p + 1; hipLaunchKernelGGL(mega_fwd, dim3(grid), dim3(NWAVES * 64), LDS_BYTES, stream, a); }
#endif
}
```

```cpp
#include <hip/hip_runtime.h>
#include <cstdio>
#include <cstdint>
#include <cmath>
#ifndef PROBE_REP
#define PROBE_REP (-1)
#endif
#ifndef PROBE_T
#define PROBE_T (-1)
#endif
template <class V> __device__ __forceinline__ void st_wt16(void* p, const V w) { static_assert(sizeof(V) == 16, "16-byte value"); asm volatile("global_store_dwordx4 %0, %1, off sc1\n\ts_nop 1" :: "v"(p), "v"(w) : "memory"); }
template <class V> __device__ __forceinline__ void st_wt8(void* p, const V w) { static_assert(sizeof(V) == 8, "8-byte value"); asm volatile("global_store_dwordx2 %0, %1, off sc1\n\ts_nop 1" :: "v"(p), "v"(w) : "memory"); }
namespace pg8 {
#define PG8_LAS __attribute__((address_space(3)))
typedef unsigned short bf16_t;
typedef short bf16x8 __attribute__((ext_vector_type(8)));
typedef float f32x4 __attribute__((ext_vector_type(4)));
typedef unsigned u32x4 __attribute__((ext_vector_type(4)));
constexpr int BM = 256, BK = 64, HALF = 128, HTB = HALF * BK * 2  , STAGE_BYTES = 8 * HTB, NXCD = 8, WGM = 8;

__host__ __device__ __forceinline__ int lds_byte(int r, int c) { const int st = (r >> 4) * 2 + (c >> 5), rr = r & 15, cc = c & 31, ob = rr * 64 + cc * 2; return st * 1024 + (ob ^ (((ob >> 9) & 1) << 5)); }
__host__ __device__ __forceinline__ void stage_rc(int b, int& R, int& C) { const int st = b / 1024, sb = b % 1024, swz = sb ^ (((sb >> 9) & 1) << 5); R = (st >> 1) * 16 + swz / 64; C = (st & 1) * 32 + (swz % 64) / 2; }
__host__ __device__ __forceinline__ int perm32(int rho) { const int n = rho >> 4, i = rho & 15; return 8 * (i >> 2) + 4 * n + (i & 3); }

struct Unit { int pm, pn; int kb = 0, nk = 0, mode = 0, slot = 0; };
struct Gemm { const bf16_t* A; const bf16_t* Bt; int M, N, K; };

struct StaticOrder {
    int nM, nN, nwg, G, c;
    __host__ __device__ void init(int M, int N, int G_, int c_) { nM = M / BM; nN = N / BM; nwg = nM * nN; G = G_; c = c_; }
    __host__ __device__ bool next(int i, Unit& u) const {
        const long L = (long)i * G + c; if (L >= nwg) return false;
        int wgid = (int)L; { const int q = nwg / NXCD, r = nwg % NXCD, xcd = wgid % NXCD, off = wgid / NXCD; wgid = (xcd < r ? xcd * (q + 1) : r * (q + 1) + (xcd - r) * q) + off; }
        const int nig = WGM * nN, gid = wgid / nig, fm = gid * WGM, gsz = (nM - fm) < WGM ? (nM - fm) : WGM;
        u.pm = fm + ((wgid % nig) % gsz); u.pn = (wgid % nig) / gsz; u.slot = i; return true;
    }
    __device__ __forceinline__ void first_tile(int& pm, int& pn) const {
        int wgid = c; { const int q = nwg / NXCD, r = nwg % NXCD, xcd = wgid % NXCD, off = wgid / NXCD; wgid = (xcd < r ? xcd * (q + 1) : r * (q + 1) + (xcd - r) * q) + off; }
        const int nig = WGM * nN, gid = wgid / nig, fm = gid * WGM, gsz = (nM - fm) < WGM ? (nM - fm) : WGM;
        pm = fm + ((wgid % nig) % gsz); pn = (wgid % nig) / gsz;
    }
    __device__ __forceinline__ void a_ready(const Unit&) const {}
    __device__ __forceinline__ void done(const Unit&) const {}
};

__device__ __forceinline__ unsigned cvt_pk_bf16(float lo, float hi) { unsigned r; asm volatile("v_cvt_pk_bf16_f32 %0, %1, %2" : "=v"(r) : "v"(lo), "v"(hi)); return r; }
template <class Epi, class Sched, bool ALIGN_EPI = false, bool SP2 = false, int PITCH = 0  >
__device__ __forceinline__ void gemm_phase(PG8_LAS unsigned char* lds, const Gemm g, const Sched& S, const Epi& E) {
    const int tid = threadIdx.x, wid = __builtin_amdgcn_readfirstlane(tid >> 6), lane = tid & 63, wr = wid >> 2, wc = wid & 3, fr = lane & 15, fq = lane >> 4;
    const int K = g.K, nt = K / BK, RP = PITCH ? PITCH : K;
    unsigned voffA[2], voffB[2];
#pragma unroll
    for (int i = 0; i < 2; ++i) { int R, C; stage_rc(tid * 16 + i * 8192, R, C); const int Rb = Epi::PERM ? ((R & ~31) + perm32(R & 31)) : R;
        voffA[i] = (unsigned)(R * RP + C) * 2u; voffB[i] = (unsigned)(Rb * RP + C) * 2u; }
    const size_t kstep = (size_t)(BK * 2);
    const size_t hstep = (size_t)HALF * RP * 2;
    const size_t tstep = 2 * hstep;
    const unsigned ldsw = (unsigned)wid * 1024u;
    const int aoff = lds_byte(wr * 64 + fr, fq * 8), boff = lds_byte(wc * 32 + fr, fq * 8);
#define PG8_SA(b, h) (((b) * 2 + (h)) * HTB)
#define PG8_SB(b, h) ((4 + (b) * 2 + (h)) * HTB)
#define PG8_STAGE(bufoff, gbase, voff) do { _Pragma("unroll") for (int _i = 0; _i < 2; ++_i) \
        __builtin_amdgcn_global_load_lds((const unsigned*)((const char*)(gbase) + (voff)[_i]), (PG8_LAS unsigned*)(lds + (bufoff) + ldsw + _i * 8192), 16, 0, 0); } while (0)
#define PG8_LDA(dst, b, h) do { _Pragma("unroll") for (int m = 0; m < 4; ++m) _Pragma("unroll") for (int k = 0; k < 2; ++k) dst[m][k] = *(const PG8_LAS bf16x8*)(lds + PG8_SA(b, h) + aoff + m * 2048 + k * 1024); } while (0)
#define PG8_LDB(dst, b, h) do { _Pragma("unroll") for (int n = 0; n < 2; ++n) _Pragma("unroll") for (int k = 0; k < 2; ++k) dst[n][k] = *(const PG8_LAS bf16x8*)(lds + PG8_SB(b, h) + boff + n * 2048 + k * 1024); } while (0)
#define PG8_MMA(ai, bj, At, Bt) do { __builtin_amdgcn_s_setprio(1); _Pragma("unroll") for (int m = 0; m < 4; ++m) _Pragma("unroll") for (int n = 0; n < 2; ++n) _Pragma("unroll") for (int k = 0; k < 2; ++k) \
        acc[ai][bj][m][n] = __builtin_amdgcn_mfma_f32_16x16x32_bf16(Bt[n][k], At[m][k], acc[ai][bj][m][n], 0, 0, 0); __builtin_amdgcn_s_setprio(0); } while (0)
#define PG8_WAIT_V(n) asm volatile("s_waitcnt vmcnt(" #n ")" ::: "memory")
#define PG8_WAIT_L(n) asm volatile("s_waitcnt lgkmcnt(" #n ")" ::: "memory")
#define PG8_BAR __builtin_amdgcn_s_barrier()
#define PG8_SCHED __builtin_amdgcn_sched_barrier(0)
    Unit cur, nxt; int ui = 0;
    if (!S.next(0, cur)) return;
    f32x4 acc[2][2][4][2];
    if constexpr (Epi::SK) { E.init_acc(acc, cur, wid); } else {
#pragma unroll
    for (int a = 0; a < 2; ++a)
#pragma unroll
        for (int b = 0; b < 2; ++b)
#pragma unroll
            for (int m = 0; m < 4; ++m)
#pragma unroll
                for (int n = 0; n < 2; ++n) acc[a][b][m][n] = (f32x4){0.f, 0.f, 0.f, 0.f};
    }
    bf16x8 At[4][2], B0[2][2], B1[2][2];
    const char* cA = (const char*)g.A + (size_t)cur.pm * tstep + (size_t)cur.kb * kstep; const char* cB = (const char*)g.Bt + (size_t)cur.pn * tstep + (size_t)cur.kb * kstep;
    S.a_ready(cur);
    if constexpr (SP2) {
        PG8_STAGE(PG8_SB(0, 0), cB, voffB); PG8_STAGE(PG8_SB(0, 1), cB + hstep, voffB); PG8_STAGE(PG8_SA(0, 0), cA, voffA); PG8_STAGE(PG8_SA(0, 1), cA + hstep, voffA);
        if (wr == 1) PG8_BAR;
        PG8_WAIT_V(2); PG8_BAR;
        PG8_STAGE(PG8_SB(1, 0), cB + kstep, voffB); PG8_STAGE(PG8_SA(1, 0), cA + kstep, voffA); PG8_STAGE(PG8_SB(1, 1), cB + hstep + kstep, voffB);
        PG8_WAIT_V(6); PG8_BAR;
    } else {
        PG8_STAGE(PG8_SB(0, 0), cB, voffB); PG8_STAGE(PG8_SA(0, 0), cA, voffA); PG8_STAGE(PG8_SB(0, 1), cB + hstep, voffB); PG8_STAGE(PG8_SA(0, 1), cA + hstep, voffA);
        if (wr == 1) PG8_BAR;
        PG8_WAIT_V(4); PG8_BAR;
        PG8_STAGE(PG8_SB(1, 0), cB + kstep, voffB); PG8_STAGE(PG8_SA(1, 0), cA + kstep, voffA); PG8_STAGE(PG8_SB(1, 1), cB + hstep + kstep, voffB);
        PG8_WAIT_V(6); PG8_BAR;
    }
    for (;;) {
        const bool has_next = S.next(ui + 1, nxt);
        const char* nA = has_next ? (const char*)g.A + (size_t)nxt.pm * tstep + (size_t)nxt.kb * kstep : cA; const char* nB = has_next ? (const char*)g.Bt + (size_t)nxt.pn * tstep + (size_t)nxt.kb * kstep : cB;
        const int ntc = cur.nk ? cur.nk : nt;
        for (int t = 0; t < ntc; t += 2) {
            const bool last = (t == ntc - 2);
            const char* a1 = cA + (size_t)(t + 1) * kstep;
            const char* a2 = last ? nA : cA + (size_t)(t + 2) * kstep; const char* b2 = last ? nB : cB + (size_t)(t + 2) * kstep;
            const char* a3 = a2 + kstep; const char* b3 = b2 + kstep;
            if (last && has_next) S.a_ready(nxt);
            if constexpr (SP2) {
            PG8_LDB(B0, 0, 0); PG8_LDB(B1, 0, 1); PG8_SCHED; PG8_LDA(At, 0, 0); PG8_STAGE(PG8_SA(1, 1), a1 + hstep, voffA);
            PG8_WAIT_V(8); PG8_WAIT_L(0); PG8_BAR; PG8_MMA(0, 0, At, B0); PG8_MMA(0, 1, At, B1); PG8_BAR; PG8_SCHED;
            PG8_LDA(At, 0, 1); PG8_STAGE(PG8_SB(0, 0), b2, voffB); PG8_STAGE(PG8_SB(0, 1), b2 + hstep, voffB); PG8_STAGE(PG8_SA(0, 0), a2, voffA);
            PG8_WAIT_V(8); PG8_WAIT_L(0); PG8_BAR; PG8_MMA(1, 0, At, B0); PG8_MMA(1, 1, At, B1); PG8_BAR; PG8_SCHED;
            PG8_LDB(B0, 1, 0); PG8_LDB(B1, 1, 1); PG8_SCHED; PG8_LDA(At, 1, 0); PG8_STAGE(PG8_SA(0, 1), a2 + hstep, voffA);
            PG8_WAIT_V(8); PG8_WAIT_L(0); PG8_BAR; PG8_MMA(0, 0, At, B0); PG8_MMA(0, 1, At, B1); PG8_BAR; PG8_SCHED;
            PG8_LDA(At, 1, 1); PG8_STAGE(PG8_SB(1, 0), b3, voffB); PG8_STAGE(PG8_SB(1, 1), b3 + hstep, voffB); PG8_STAGE(PG8_SA(1, 0), a3, voffA);
            PG8_WAIT_V(8); PG8_WAIT_L(0); PG8_BAR; PG8_MMA(1, 0, At, B0); PG8_MMA(1, 1, At, B1); PG8_BAR; PG8_SCHED;
            } else {
            PG8_LDB(B0, 0, 0); PG8_SCHED; PG8_LDA(At, 0, 0); PG8_STAGE(PG8_SA(1, 1), a1 + hstep, voffA);
            PG8_WAIT_L(8); PG8_BAR; PG8_WAIT_L(0); PG8_MMA(0, 0, At, B0); PG8_BAR; PG8_SCHED;
            PG8_LDB(B1, 0, 1); PG8_STAGE(PG8_SB(0, 0), b2, voffB);
            PG8_BAR; PG8_WAIT_L(0); PG8_MMA(0, 1, At, B1); PG8_BAR;
            PG8_LDA(At, 0, 1); PG8_STAGE(PG8_SA(0, 0), a2, voffA);
            PG8_BAR; PG8_WAIT_L(0); PG8_MMA(1, 0, At, B0); PG8_BAR; PG8_SCHED;
            PG8_STAGE(PG8_SB(0, 1), b2 + hstep, voffB);
            PG8_WAIT_V(6); PG8_BAR; PG8_MMA(1, 1, At, B1); PG8_BAR;
            PG8_LDB(B0, 1, 0); PG8_SCHED; PG8_LDA(At, 1, 0); PG8_STAGE(PG8_SA(0, 1), a2 + hstep, voffA);
            PG8_WAIT_L(8); PG8_BAR; PG8_WAIT_L(0); PG8_MMA(0, 0, At, B0); PG8_BAR; PG8_SCHED;
            PG8_LDB(B1, 1, 1); PG8_STAGE(PG8_SB(1, 0), b3, voffB);
            PG8_BAR; PG8_WAIT_L(0); PG8_MMA(0, 1, At, B1); PG8_BAR;
            PG8_LDA(At, 1, 1); PG8_STAGE(PG8_SA(1, 0), a3, voffA);
            PG8_BAR; PG8_WAIT_L(0); PG8_MMA(1, 0, At, B0); PG8_BAR; PG8_SCHED;
            PG8_STAGE(PG8_SB(1, 1), b3 + hstep, voffB);
            PG8_WAIT_V(6); PG8_BAR; PG8_MMA(1, 1, At, B1); PG8_BAR;
            }
        }
        if constexpr (ALIGN_EPI) { if (wr == 0) PG8_BAR; }
        if constexpr (!Epi::AFTER_DRAIN) { E(acc, cur, wr, wc, fr, fq); S.done(cur); }
        if (!has_next) break;
        if constexpr (Epi::SK) { E.init_acc(acc, nxt, wid); } else {
#pragma unroll
        for (int a = 0; a < 2; ++a)
#pragma unroll
            for (int b = 0; b < 2; ++b)
#pragma unroll
                for (int m = 0; m < 4; ++m)
#pragma unroll
                    for (int n = 0; n < 2; ++n) acc[a][b][m][n] = (f32x4){0.f, 0.f, 0.f, 0.f};
        }
        cur = nxt; cA = nA; cB = nB; ++ui;
        if constexpr (ALIGN_EPI) { if (wr == 1) PG8_BAR; }
    }
    PG8_WAIT_V(0);
    if constexpr (!ALIGN_EPI) { if (wr == 0) PG8_BAR; }
    PG8_BAR;
    if constexpr (Epi::AFTER_DRAIN) { E.fused(acc, cur, wr, wc, fr, fq, lds, wid, lane); S.done(cur); }
#undef PG8_SA
#undef PG8_SB
#undef PG8_STAGE
#undef PG8_LDA
#undef PG8_LDB
#undef PG8_MMA
#undef PG8_WAIT_V
#undef PG8_WAIT_L
#undef PG8_BAR
#undef PG8_SCHED
}
typedef int i32x4 __attribute__((ext_vector_type(4)));
typedef int i32x8 __attribute__((ext_vector_type(8)));
template <class Epi, class Sched, bool ALIGN_EPI, bool SP2, int PITCH = 0>
__device__ __forceinline__ void gemm_phase8(PG8_LAS unsigned char* lds, const Gemm g, const Sched& S, const Epi& E, const int wid  ) {
    int lane; asm volatile("v_mbcnt_lo_u32_b32 %0, -1, 0\n\tv_mbcnt_hi_u32_b32 %0, -1, %0" : "=v"(lane));
    const int tid = wid * 64 + lane, wr = wid >> 2, wc = wid & 3, fr = lane & 15, fq = lane >> 4;
    const int K = g.K, rowb = PITCH ? PITCH : K, nt = K / 128;
    unsigned voffA[2], voffB[2];
#pragma unroll
    for (int i = 0; i < 2; ++i) { int R, C; stage_rc(tid * 16 + i * 8192, R, C); const int Rb = Epi::PERM ? ((R & ~31) + perm32(R & 31)) : R;
        voffA[i] = (unsigned)(R * rowb + C * 2); voffB[i] = (unsigned)(Rb * rowb + C * 2); }
    const size_t kstep = (size_t)(BK * 2);
    const size_t hstep = (size_t)HALF * rowb;
    const size_t tstep = 2 * hstep;
    const unsigned ldsw = (unsigned)wid * 1024u;
    const unsigned ldsbase_ = (unsigned)__builtin_amdgcn_readfirstlane((int)((unsigned)(unsigned long long)(const void*)lds + ldsw));
    const int c8 = 32 * (fq >> 1) + 16 * (fq & 1);
    const int aoff0 = lds_byte(wr * 64 + fr, c8), boff0 = lds_byte(wc * 32 + fr, c8);
#define PG8_SA(b, h) (((b) * 2 + (h)) * HTB)
#define PG8_SB(b, h) ((4 + (b) * 2 + (h)) * HTB)
#define PG8_STAGE(bufoff, gbase, voff) do { _Pragma("unroll") for (int _i = 0; _i < 2; ++_i) { unsigned keep_; \
        asm volatile("s_mov_b32 %0, m0\n\ts_mov_b32 m0, %1\n\ts_nop 0\n\tglobal_load_lds_dwordx4 %2, %3\n\ts_mov_b32 m0, %0" : "=&s"(keep_) : "s"(ldsbase_ + (unsigned)((bufoff) + _i * 8192)), "v"((voff)[_i]), "s"((const char*)(gbase)) : "memory"); } } while (0)
#define PG8_LDA(dst, b, h) do { _Pragma("unroll") for (int m = 0; m < 4; ++m) dst[m] = *(const PG8_LAS i32x8*)(lds + PG8_SA(b, h) + aoff0 + m * 2048); } while (0)
#define PG8_LDB(dst, b, h) do { _Pragma("unroll") for (int n = 0; n < 2; ++n) dst[n] = *(const PG8_LAS i32x8*)(lds + PG8_SB(b, h) + boff0 + n * 2048); } while (0)
#define PG8_MMA(ai, bj, At, Bt) do { __builtin_amdgcn_s_setprio(1); _Pragma("unroll") for (int m = 0; m < 4; ++m) _Pragma("unroll") for (int n = 0; n < 2; ++n) \
        acc[ai][bj][m][n] = __builtin_amdgcn_mfma_scale_f32_16x16x128_f8f6f4(Bt[n], At[m], acc[ai][bj][m][n], 0, 0, 0, 0, 0, 0);     __builtin_amdgcn_s_setprio(0); } while (0)
#define PG8_WAIT_V(n) asm volatile("s_waitcnt vmcnt(" #n ")" ::: "memory")
#define PG8_WAIT_L(n) asm volatile("s_waitcnt lgkmcnt(" #n ")" ::: "memory")
#define PG8_BAR __builtin_amdgcn_s_barrier()
#define PG8_SCHED __builtin_amdgcn_sched_barrier(0)
    Unit cur, nxt; int ui = 0;
    if (!S.next(0, cur)) return;
    f32x4 acc[2][2][4][2];
    if constexpr (Epi::SK) { E.init_acc(acc, cur, wid); } else {
#pragma unroll
    for (int a = 0; a < 2; ++a)
#pragma unroll
        for (int b = 0; b < 2; ++b)
#pragma unroll
            for (int m = 0; m < 4; ++m)
#pragma unroll
                for (int n = 0; n < 2; ++n) acc[a][b][m][n] = (f32x4){0.f, 0.f, 0.f, 0.f};
    }
    i32x8 At[4], B0[2], B1[2];
    const char* cA = (const char*)g.A + (size_t)cur.pm * tstep + (size_t)cur.kb * kstep; const char* cB = (const char*)g.Bt + (size_t)cur.pn * tstep + (size_t)cur.kb * kstep;
    S.a_ready(cur);
    if constexpr (SP2) {
        PG8_STAGE(PG8_SB(0, 0), cB, voffB); PG8_STAGE(PG8_SB(0, 1), cB + hstep, voffB); PG8_STAGE(PG8_SA(0, 0), cA, voffA); PG8_STAGE(PG8_SA(0, 1), cA + hstep, voffA);
        if (wr == 1) PG8_BAR;
        PG8_WAIT_V(2); PG8_BAR;
        PG8_STAGE(PG8_SB(1, 0), cB + kstep, voffB); PG8_STAGE(PG8_SA(1, 0), cA + kstep, voffA); PG8_STAGE(PG8_SB(1, 1), cB + hstep + kstep, voffB);
        PG8_WAIT_V(6); PG8_BAR;
    } else {
        PG8_STAGE(PG8_SB(0, 0), cB, voffB); PG8_STAGE(PG8_SA(0, 0), cA, voffA); PG8_STAGE(PG8_SB(0, 1), cB + hstep, voffB); PG8_STAGE(PG8_SA(0, 1), cA + hstep, voffA);
        if (wr == 1) PG8_BAR;
        PG8_WAIT_V(4); PG8_BAR;
        PG8_STAGE(PG8_SB(1, 0), cB + kstep, voffB); PG8_STAGE(PG8_SA(1, 0), cA + kstep, voffA); PG8_STAGE(PG8_SB(1, 1), cB + hstep + kstep, voffB);
        PG8_WAIT_V(6); PG8_BAR;
    }
    for (;;) {
        const bool has_next = S.next(ui + 1, nxt);
        const char* nA = has_next ? (const char*)g.A + (size_t)nxt.pm * tstep + (size_t)nxt.kb * kstep : cA; const char* nB = has_next ? (const char*)g.Bt + (size_t)nxt.pn * tstep + (size_t)nxt.kb * kstep : cB;
        const int ntc = cur.nk ? cur.nk : nt;
        for (int t = 0; t < ntc; t += 2) {
            const bool last = (t == ntc - 2);
            const char* a1 = cA + (size_t)(t + 1) * kstep;
            const char* a2 = last ? nA : cA + (size_t)(t + 2) * kstep; const char* b2 = last ? nB : cB + (size_t)(t + 2) * kstep;
            const char* a3 = a2 + kstep; const char* b3 = b2 + kstep;
            if (last && has_next) S.a_ready(nxt);
            if constexpr (SP2) {
            PG8_LDB(B0, 0, 0); PG8_LDB(B1, 0, 1); PG8_SCHED; PG8_LDA(At, 0, 0); PG8_STAGE(PG8_SA(1, 1), a1 + hstep, voffA);
            PG8_WAIT_V(8); PG8_WAIT_L(0); PG8_BAR; PG8_MMA(0, 0, At, B0); PG8_MMA(0, 1, At, B1); PG8_BAR; PG8_SCHED;
            PG8_LDA(At, 0, 1); PG8_STAGE(PG8_SB(0, 0), b2, voffB); PG8_STAGE(PG8_SB(0, 1), b2 + hstep, voffB); PG8_STAGE(PG8_SA(0, 0), a2, voffA);
            PG8_WAIT_V(8); PG8_WAIT_L(0); PG8_BAR; PG8_MMA(1, 0, At, B0); PG8_MMA(1, 1, At, B1); PG8_BAR; PG8_SCHED;
            PG8_LDB(B0, 1, 0); PG8_LDB(B1, 1, 1); PG8_SCHED; PG8_LDA(At, 1, 0); PG8_STAGE(PG8_SA(0, 1), a2 + hstep, voffA);
            PG8_WAIT_V(8); PG8_WAIT_L(0); PG8_BAR; PG8_MMA(0, 0, At, B0); PG8_MMA(0, 1, At, B1); PG8_BAR; PG8_SCHED;
            PG8_LDA(At, 1, 1); PG8_STAGE(PG8_SB(1, 0), b3, voffB); PG8_STAGE(PG8_SB(1, 1), b3 + hstep, voffB); PG8_STAGE(PG8_SA(1, 0), a3, voffA);
            PG8_WAIT_V(8); PG8_WAIT_L(0); PG8_BAR; PG8_MMA(1, 0, At, B0); PG8_MMA(1, 1, At, B1); PG8_BAR; PG8_SCHED;
            } else {
            PG8_LDB(B0, 0, 0); PG8_SCHED; PG8_LDA(At, 0, 0); PG8_STAGE(PG8_SA(1, 1), a1 + hstep, voffA);
            PG8_WAIT_L(8); PG8_BAR; PG8_WAIT_L(0); PG8_MMA(0, 0, At, B0); PG8_BAR; PG8_SCHED;
            PG8_LDB(B1, 0, 1); PG8_STAGE(PG8_SB(0, 0), b2, voffB);
            PG8_BAR; PG8_WAIT_L(0); PG8_MMA(0, 1, At, B1); PG8_BAR;
            PG8_LDA(At, 0, 1); PG8_STAGE(PG8_SA(0, 0), a2, voffA);
            PG8_BAR; PG8_WAIT_L(0); PG8_MMA(1, 0, At, B0); PG8_BAR; PG8_SCHED;
            PG8_STAGE(PG8_SB(0, 1), b2 + hstep, voffB);
            PG8_WAIT_V(6); PG8_BAR; PG8_MMA(1, 1, At, B1); PG8_BAR;
            PG8_LDB(B0, 1, 0); PG8_SCHED; PG8_LDA(At, 1, 0); PG8_STAGE(PG8_SA(0, 1), a2 + hstep, voffA);
            PG8_WAIT_L(8); PG8_BAR; PG8_WAIT_L(0); PG8_MMA(0, 0, At, B0); PG8_BAR; PG8_SCHED;
            PG8_LDB(B1, 1, 1); PG8_STAGE(PG8_SB(1, 0), b3, voffB);
            PG8_BAR; PG8_WAIT_L(0); PG8_MMA(0, 1, At, B1); PG8_BAR;
            PG8_LDA(At, 1, 1); PG8_STAGE(PG8_SA(1, 0), a3, voffA);
            PG8_BAR; PG8_WAIT_L(0); PG8_MMA(1, 0, At, B0); PG8_BAR; PG8_SCHED;
            PG8_STAGE(PG8_SB(1, 1), b3 + hstep, voffB);
            PG8_WAIT_V(6); PG8_BAR; PG8_MMA(1, 1, At, B1); PG8_BAR;
            }
        }
        if constexpr (ALIGN_EPI) { if (wr == 0) PG8_BAR; }
        if constexpr (!Epi::AFTER_DRAIN) { int fr_ = fr, fq_ = fq; asm volatile("" : "+v"(fr_), "+v"(fq_));
            E(acc, cur, wr, wc, fr_, fq_); S.done(cur); }
        if (!has_next) break;
        if constexpr (Epi::SK) { E.init_acc(acc, nxt, wid); } else {
#pragma unroll
        for (int a = 0; a < 2; ++a)
#pragma unroll
            for (int b = 0; b < 2; ++b)
#pragma unroll
                for (int m = 0; m < 4; ++m)
#pragma unroll
                    for (int n = 0; n < 2; ++n) acc[a][b][m][n] = (f32x4){0.f, 0.f, 0.f, 0.f};
        }
        cur = nxt; cA = nA; cB = nB; ++ui;
        if constexpr (ALIGN_EPI) { if (wr == 1) PG8_BAR; }
    }
    PG8_WAIT_V(0);
    if constexpr (!ALIGN_EPI) { if (wr == 0) PG8_BAR; }
    PG8_BAR;
    if constexpr (Epi::AFTER_DRAIN) { E.fused(acc, cur, wr, wc, fr, fq, lds, wid, lane); S.done(cur); }
#undef PG8_SA
#undef PG8_SB
#undef PG8_STAGE
#undef PG8_LDA
#undef PG8_LDB
#undef PG8_MMA
#undef PG8_WAIT_V
#undef PG8_WAIT_L
#undef PG8_BAR
#undef PG8_SCHED
}
}
#define GAS __attribute__((address_space(1)))
#define LAS __attribute__((address_space(3)))
typedef unsigned short bf16;
typedef unsigned v4u __attribute__((ext_vector_type(4)));
typedef float f32x4 __attribute__((ext_vector_type(4)));
typedef short bf16x8 __attribute__((ext_vector_type(8)));
typedef GAS unsigned gu32;
typedef GAS unsigned long long gu64;
#define RLX_AGENT __ATOMIC_RELAXED, __HIP_MEMORY_SCOPE_AGENT
#define LDS_WAIT() asm volatile("s_waitcnt lgkmcnt(0)" ::: "memory")
#define VM_WAIT() asm volatile("s_waitcnt vmcnt(0)" ::: "memory")
__device__ __forceinline__ unsigned long long rt() { return __builtin_amdgcn_s_memrealtime(); }
__device__ __forceinline__ unsigned f2bf(float f) { unsigned u = __builtin_bit_cast(unsigned, f); return (u + 0x7fffu + ((u >> 16) & 1u)) >> 16; }
__device__ __forceinline__ unsigned pk2(float lo, float hi) { return f2bf(lo) | (f2bf(hi) << 16); }

#define XB_TMO      128
#define XB_XCNT(j)  (256  + 64 * (j))
#define XB_XSUB(j)  (1280 + 64 * (j))
#define XB_XGEN(j)  (2304 + 64 * (j))
#define XB_TOP      3328
#define XB_TOPGEN   3392
#define XCD_BAR_WORDS 3456
#define XB_SPIN_CAP (1u << 18)

__device__ __forceinline__ unsigned xb_ld(unsigned* p)              { return __hip_atomic_load(p, __ATOMIC_RELAXED, __HIP_MEMORY_SCOPE_AGENT); }
__device__ __forceinline__ unsigned xb_add(unsigned* p, unsigned v) { return __hip_atomic_fetch_add(p, v, __ATOMIC_RELAXED, __HIP_MEMORY_SCOPE_AGENT); }
__device__ __forceinline__ unsigned xb_xcc_id() { return (unsigned)__builtin_amdgcn_s_getreg((3 << 11) | 20) & 0xFu; }
#define XB_SPIN(cond, bar) do { unsigned _sp = 0; while (cond) { __builtin_amdgcn_s_sleep(1); \
    if ((++_sp & 255u) == 0u) { if (xb_ld(&(bar)[XB_TMO])) break; if (_sp > XB_SPIN_CAP) { atomicAdd(&(bar)[XB_TMO], 1u); break; } } } } while (0)

struct XcdBarrier {
    unsigned* bar; unsigned x;
    volatile LAS unsigned* st;
};

__device__ __forceinline__ XcdBarrier xcd_barrier_post(unsigned* bar, volatile LAS unsigned* st) {
    XcdBarrier b; b.bar = bar; b.x = xb_xcc_id(); b.st = st;
    if (threadIdx.x == 0) (void)xb_add(&bar[XB_XCNT(b.x)], 1u);
    return b;
}
__device__ __forceinline__ void xcd_barrier_complete(unsigned* bar, unsigned x, unsigned& nloc, unsigned& nx) {
    const unsigned G = gridDim.x * gridDim.y * gridDim.z;
    unsigned sum, cnt, mine, sp = 0u;
    for (;;) {
        sum = 0u; cnt = 0u; mine = 0u;
#pragma unroll
        for (unsigned j = 0; j < 16; ++j) { const unsigned c = xb_ld(&bar[XB_XCNT(j)]); sum += c; cnt += (c > 0u) ? 1u : 0u; mine = (j == x) ? c : mine; }
        if (sum == G) break;
        __builtin_amdgcn_s_sleep(1);
        if ((++sp & 255u) == 0u) { if (xb_ld(&bar[XB_TMO])) break; if (sp > XB_SPIN_CAP) { atomicAdd(&bar[XB_TMO], 1u); break; } }
    }
    nloc = mine > 0u ? mine : 1u; nx = cnt > 0u ? cnt : 1u;
}

__device__ __forceinline__ void xcd_barrier(const XcdBarrier& b, const bool leader_thread  ) {
    asm volatile("s_waitcnt vmcnt(0)" ::: "memory");
    __syncthreads();
    if (leader_thread) {
        unsigned* bar = b.bar;
        __builtin_amdgcn_s_waitcnt(0);
        unsigned nloc = b.st[0], nx = b.st[1];
        if (nloc == 0u) { xcd_barrier_complete(bar, b.x, nloc, nx); b.st[0] = nloc; b.st[1] = nx; }
        const unsigned old = xb_add(&bar[XB_XSUB(b.x)], 1u);
        const unsigned gen = old / nloc;
        if (old + 1u == (gen + 1u) * nloc) {
            __builtin_amdgcn_fence(__ATOMIC_RELEASE, "agent");
            asm volatile("s_waitcnt vmcnt(0)" ::: "memory");
            (void)xb_add(&bar[XB_TOP], 1u);
        }
        { const unsigned target = (gen + 1u) * nx; XB_SPIN(xb_ld(&bar[XB_TOP]) < target, bar); }
        __builtin_amdgcn_fence(__ATOMIC_ACQUIRE, "agent");
        asm volatile("s_waitcnt vmcnt(0)" ::: "memory");
    }
    __syncthreads();
}

__device__ __forceinline__ void flat_barrier(unsigned* sh, const unsigned target, unsigned* bar, const int wave, const int lane, const int bid) {
    asm volatile("s_waitcnt vmcnt(0)" ::: "memory");
    __syncthreads();
    if (wave == 0) {
        if (lane == 0) (void)xb_add(sh + (bid & 63) * 16, 1u);
        XB_SPIN(xb_ld(sh + lane * 16) < target, bar);
        __builtin_amdgcn_fence(__ATOMIC_ACQUIRE, "agent");
        asm volatile("s_waitcnt vmcnt(0)" ::: "memory");
    }
    __syncthreads();
}

constexpr int NB = 2, SEQ = 8192, T = NB * SEQ, DM = 1024;
constexpr int NPROJ = 3072, INTOT = 3088;
constexpr int FFD = 2816, FFE = 3584, NEXP = 8;
constexpr float EPS = 1e-6f;
constexpr float LOG2E = 1.4426950408889634f;
constexpr float C2Q = 0.125f * LOG2E;
constexpr int PC_Q = 0, PC_K = 512, PC_V = 1024, PC_CB = 1536, PC_CC = 1792, PC_CH = 2048, PC_GQ = 2304, PC_GK = 2432, PC_GV = 2560, PC_GO = 2816;
constexpr int NWAVES = 8;
constexpr int MOE_MAXSLOT = 34816;

constexpr size_t MiB = 1u << 20;
constexpr size_t WS_CTL = 0, CTL_ZERO_BYTES = 128 * 1024;
constexpr size_t WS_ROPE = 1 * MiB;
constexpr size_t WS_RG = 3 * MiB;
constexpr size_t WS_WGZ = 3 * MiB + 64 * 1024;
constexpr size_t WS_BLKCNT = 3 * MiB + 128 * 1024;
constexpr size_t WS_PANEL = 3 * MiB + 192 * 1024;
constexpr size_t WS_TOKE = 4 * MiB;
constexpr size_t WS_TOKW = 4 * MiB + 128 * 1024;
constexpr size_t WS_TOKS = 4 * MiB + 256 * 1024;
constexpr size_t WS_SRSTD = 4 * MiB + 384 * 1024;
constexpr size_t WS_GZ = 5 * MiB;
constexpr size_t WS_WIN = 6 * MiB;
constexpr size_t WS_WOUT = 18 * MiB;
constexpr size_t WS_WGU = 22 * MiB;
constexpr size_t WS_WD = 33 * MiB;
constexpr size_t WS_EGU = 39 * MiB;
constexpr size_t WS_ED = 95 * MiB;
constexpr int FFE_PITCH = 3712;
constexpr size_t WS_HB = 124 * MiB;
constexpr size_t WS_SSP = 156 * MiB;
constexpr size_t WS_DYN = 160 * MiB;
constexpr size_t WS_PROJ = WS_DYN;
constexpr size_t WS_MIX = WS_DYN + 96 * MiB;
constexpr size_t WS_ACT = WS_DYN;
constexpr int FFD_PITCH = 2880;
constexpr size_t WS_ASORT = WS_DYN;
constexpr size_t WS_Y = WS_DYN + 34 * MiB;
constexpr size_t WS_YP = WS_DYN;
constexpr int MOE_TAIL_P = 7, MOE_TAIL_ROW0 = 32768, MOE_TAIL_ROWS = 2048;
constexpr size_t WS_EACT = WS_DYN + 102 * MiB;
constexpr size_t WS_END = WS_DYN + 226 * MiB;
constexpr size_t WS_SKP_FFN = WS_DYN + 100 * MiB;
constexpr float W8_UP = 32.f, W8_DN = 64.f;
constexpr int CW_TMO = 0, CW_BAR = 4096, CW_SKF = 8192, CW_GLAB = 20480, CW_PAN = 24576, CW_FLAT = 28672;
static_assert((CW_GLAB + 4 * 64) <= CW_PAN && (CW_PAN + 2 * 64 * 16) <= CW_FLAT && (CW_FLAT + 64 * 16) * 4 <= (int)CTL_ZERO_BYTES && (CW_BAR + XCD_BAR_WORDS) <= CW_SKF && CW_SKF + 2 * 4096 <= CW_GLAB, "control words inside the zeroed span");

constexpr int RING_OFF = 0, RING_BYTES = 131072;
constexpr int LDSCTL_OFF = 135168, MISC_OFF = LDSCTL_OFF + 320;
constexpr int LDS_BYTES = 147456;

__device__ __forceinline__ float bf2f(unsigned short b) { return __uint_as_float(((unsigned)b) << 16); }
__device__ __forceinline__ float bflo(unsigned w) { return __uint_as_float(w << 16); }
__device__ __forceinline__ float bfhi(unsigned w) { return __uint_as_float(w & 0xffff0000u); }
__device__ __forceinline__ float wave_sum(float v) {
#pragma unroll
    for (int o = 1; o < 64; o <<= 1) v += __shfl_xor(v, o);
    return v;
}
__device__ __forceinline__ float fast_exp2(float x) { return __builtin_amdgcn_exp2f(x); }
__device__ __forceinline__ float fast_rcp(float x) { return __builtin_amdgcn_rcpf(x); }
__device__ __forceinline__ float sigmoidf_(float x) { return fast_rcp(1.0f + fast_exp2(-x * LOG2E)); }

__device__ __forceinline__ float row_rstd(const float* ssp, int row) {
    const float4 a = *(const float4*)(ssp + (size_t)row * 16), b = *(const float4*)(ssp + (size_t)row * 16 + 4), c = *(const float4*)(ssp + (size_t)row * 16 + 8), d = *(const float4*)(ssp + (size_t)row * 16 + 12);
    const float s = ((a.x + a.y) + (a.z + a.w)) + ((b.x + b.y) + (b.z + b.w)) + ((c.x + c.y) + (c.z + c.w)) + ((d.x + d.y) + (d.z + d.w));
    return 1.0f / sqrtf(s * (1.0f / DM) + EPS);
}

constexpr int RSTD_CACHE_OFF = LDSCTL_OFF + 4608, RSTD_CACHE_MAX = 6;

namespace pg8 {
struct EpiProj {
    static constexpr bool PERM = true, AFTER_DRAIN = false, SK = false;
    bf16_t* O; const PG8_LAS float* rc; const float* rope;
    __device__ __forceinline__ void operator()(const f32x4 (&acc)[2][2][4][2], const Unit& u, int wr, int wc, int fr, int fq) const {
        const int row0 = u.pm * BM + wr * 64 + fr, colb = u.pn * BM + wc * 32 + 8 * fq;
        const bool isrope = u.pn < 4; const float qs = (u.pn < 2) ? C2Q : 1.0f;
        const int i0 = 16 * (wc & 1) + 4 * fq;
        f32x4 csv[16];
#pragma unroll
        for (int q = 0; q < 16; ++q) csv[q] = (f32x4){1.f, 0.f, 1.f, 0.f};
        if (isrope) {
#pragma unroll
            for (int q = 0; q < 8; ++q) { const int row = row0 + (q >> 2) * HALF + (q & 3) * 16; const float* rp = rope + ((size_t)(row & (SEQ - 1)) * 32 + i0) * 2; csv[2 * q] = *(const f32x4*)rp; csv[2 * q + 1] = *(const f32x4*)(rp + 4); }
            asm volatile("" : "+v"(csv[0]), "+v"(csv[1]), "+v"(csv[2]), "+v"(csv[3]), "+v"(csv[4]), "+v"(csv[5]), "+v"(csv[6]), "+v"(csv[7]), "+v"(csv[8]), "+v"(csv[9]), "+v"(csv[10]), "+v"(csv[11]), "+v"(csv[12]), "+v"(csv[13]), "+v"(csv[14]), "+v"(csv[15]));
        }
#pragma unroll
        for (int ai = 0; ai < 2; ++ai)
#pragma unroll
            for (int m = 0; m < 4; ++m) {
                const int row = row0 + ai * HALF + m * 16;
                const float rstd = rc[u.slot * 256 + wr * 64 + fr + ai * HALF + m * 16];
                const f32x4 cs0 = csv[2 * (ai * 4 + m)], cs1 = csv[2 * (ai * 4 + m) + 1];
                bf16_t* rowp = O + (size_t)row * NPROJ + colb;
#pragma unroll
                for (int bj = 0; bj < 2; ++bj) {
                    f32x4 v0 = acc[ai][bj][m][0] * rstd, v1 = acc[ai][bj][m][1] * rstd;
                    if (isrope) {
                        f32x4 w0, w1;
                        w0[0] = v0[0] * cs0[0] - v0[1] * cs0[1]; w0[1] = v0[0] * cs0[1] + v0[1] * cs0[0];
                        w0[2] = v0[2] * cs0[2] - v0[3] * cs0[3]; w0[3] = v0[2] * cs0[3] + v0[3] * cs0[2];
                        w1[0] = v1[0] * cs1[0] - v1[1] * cs1[1]; w1[1] = v1[0] * cs1[1] + v1[1] * cs1[0];
                        w1[2] = v1[2] * cs1[2] - v1[3] * cs1[3]; w1[3] = v1[2] * cs1[3] + v1[3] * cs1[2];
                        v0 = w0 * qs; v1 = w1 * qs;
                    }
                    u32x4 w; w.x = cvt_pk_bf16(v0[0], v0[1]); w.y = cvt_pk_bf16(v0[2], v0[3]); w.z = cvt_pk_bf16(v1[0], v1[1]); w.w = cvt_pk_bf16(v1[2], v1[3]);
                    st_wt16(rowp + bj * HALF, w);
                }
            }
    }
};
struct EpiResid {
    static constexpr bool PERM = true, AFTER_DRAIN = false, SK = false;
    bf16_t* hb; float* ssout;
    __device__ __forceinline__ void operator()(const f32x4 (&acc)[2][2][4][2], const Unit& u, int wr, int wc, int fr, int fq) const {
        const int row0 = u.pm * BM + wr * 64 + fr, colb = u.pn * BM + wc * 32 + 8 * fq;
        u32x4 bv[16];
#pragma unroll
        for (int q = 0; q < 16; ++q) bv[q] = *(const u32x4*)(hb + (size_t)(row0 + (q >> 3) * HALF + ((q >> 1) & 3) * 16) * DM + colb + (q & 1) * HALF);
        asm volatile("" : "+v"(bv[0]), "+v"(bv[1]), "+v"(bv[2]), "+v"(bv[3]), "+v"(bv[4]), "+v"(bv[5]), "+v"(bv[6]), "+v"(bv[7]), "+v"(bv[8]), "+v"(bv[9]), "+v"(bv[10]), "+v"(bv[11]), "+v"(bv[12]), "+v"(bv[13]), "+v"(bv[14]), "+v"(bv[15]));
#pragma unroll
        for (int ai = 0; ai < 2; ++ai)
#pragma unroll
            for (int m = 0; m < 4; ++m) {
                const int row = row0 + ai * HALF + m * 16; const size_t off = (size_t)row * DM + colb; float sq = 0.f;
#pragma unroll
                for (int bj = 0; bj < 2; ++bj) {
                    const u32x4 b = bv[ai * 8 + m * 2 + bj];
                    const f32x4 v0 = acc[ai][bj][m][0] + (f32x4){bflo(b.x), bfhi(b.x), bflo(b.y), bfhi(b.y)}, v1 = acc[ai][bj][m][1] + (f32x4){bflo(b.z), bfhi(b.z), bflo(b.w), bfhi(b.w)};
                    u32x4 w; w.x = cvt_pk_bf16(v0[0], v0[1]); w.y = cvt_pk_bf16(v0[2], v0[3]); w.z = cvt_pk_bf16(v1[0], v1[1]); w.w = cvt_pk_bf16(v1[2], v1[3]);
                    *(u32x4*)(hb + off + bj * HALF) = w;
                    const float r0 = bflo(w.x), r1 = bfhi(w.x), r2 = bflo(w.y), r3 = bfhi(w.y), r4 = bflo(w.z), r5 = bfhi(w.z), r6 = bflo(w.w), r7 = bfhi(w.w);
                    sq += (r0 * r0 + r1 * r1) + (r2 * r2 + r3 * r3) + (r4 * r4 + r5 * r5) + (r6 * r6 + r7 * r7);
                }
                sq += __shfl_xor(sq, 16); sq += __shfl_xor(sq, 32);
                if (fq == 0) ssout[(size_t)row * 16 + u.pn * 4 + wc] = sq;
            }
    }
};
__device__ __forceinline__ unsigned pk4_fp8(float a, float b, float c, float d) {
    a = fminf(fmaxf(a, -448.f), 448.f); b = fminf(fmaxf(b, -448.f), 448.f); c = fminf(fmaxf(c, -448.f), 448.f); d = fminf(fmaxf(d, -448.f), 448.f);
    int p = 0; p = __builtin_amdgcn_cvt_pk_fp8_f32(a, b, p, false); p = __builtin_amdgcn_cvt_pk_fp8_f32(c, d, p, true); return (unsigned)p; }
struct EpiSwiglu8 {
    static constexpr bool PERM = true, AFTER_DRAIN = false, SK = false;
    unsigned char* O; int ldo; const float* rstdv; int row_off; int ntile;
    __device__ __forceinline__ void operator()(const f32x4 (&acc)[2][2][4][2], const Unit& u, int wr, int wc, int fr, int fq) const {
        const int row0 = u.pm * BM + wr * 64 + fr, col = (u.pn % ntile) * HALF + wc * 32 + 8 * fq;
        float rsv[8];
#pragma unroll
        for (int q = 0; q < 8; ++q) rsv[q] = rstdv[row0 + (q >> 2) * HALF + (q & 3) * 16];
        asm volatile("" : "+v"(rsv[0]), "+v"(rsv[1]), "+v"(rsv[2]), "+v"(rsv[3]), "+v"(rsv[4]), "+v"(rsv[5]), "+v"(rsv[6]), "+v"(rsv[7]));
#pragma unroll
        for (int ai = 0; ai < 2; ++ai)
#pragma unroll
            for (int m = 0; m < 4; ++m) {
                const int row = row0 + ai * HALF + m * 16;
                const float rstd = rsv[ai * 4 + m] * (1.0f / W8_UP), rstd2 = rstd * rstd, nrl = -rstd * LOG2E;
                float a[8];
#pragma unroll
                for (int n = 0; n < 2; ++n)
#pragma unroll
                    for (int j = 0; j < 4; ++j) { const float ga = acc[ai][0][m][n][j], ua = acc[ai][1][m][n][j]; a[n * 4 + j] = (ga * ua) * (rstd2 * fast_rcp(1.0f + fast_exp2(ga * nrl))); }
                typedef unsigned u32x2 __attribute__((ext_vector_type(2)));
                u32x2 w; w.x = pk4_fp8(a[0], a[1], a[2], a[3]); w.y = pk4_fp8(a[4], a[5], a[6], a[7]);
                *(u32x2*)(O + (size_t)(row - row_off) * ldo + col) = w;
            }
    }
};
struct EpiSwiglu {
    static constexpr bool PERM = true, AFTER_DRAIN = false, SK = false;
    bf16_t* O; int ldo; const PG8_LAS float* rc; const float* rstdv; int row_off; int ntile;
    __device__ __forceinline__ void operator()(const f32x4 (&acc)[2][2][4][2], const Unit& u, int wr, int wc, int fr, int fq) const {
        const int row0 = u.pm * BM + wr * 64 + fr, col = (u.pn % ntile) * HALF + wc * 32 + 8 * fq;
        float rsv[8];
#pragma unroll
        for (int q = 0; q < 8; ++q) { const int rr = (q >> 2) * HALF + (q & 3) * 16; rsv[q] = rstdv ? rstdv[row0 + rr] : rc[u.slot * 256 + wr * 64 + fr + rr]; }
        asm volatile("" : "+v"(rsv[0]), "+v"(rsv[1]), "+v"(rsv[2]), "+v"(rsv[3]), "+v"(rsv[4]), "+v"(rsv[5]), "+v"(rsv[6]), "+v"(rsv[7]));
#pragma unroll
        for (int ai = 0; ai < 2; ++ai)
#pragma unroll
            for (int m = 0; m < 4; ++m) {
                const int row = row0 + ai * HALF + m * 16;
                const float rstd = rsv[ai * 4 + m], rstd2 = rstd * rstd, nrl = -rstd * LOG2E;
                float a[8];
#pragma unroll
                for (int n = 0; n < 2; ++n)
#pragma unroll
                    for (int j = 0; j < 4; ++j) { const float ga = acc[ai][0][m][n][j], ua = acc[ai][1][m][n][j]; a[n * 4 + j] = (ga * ua) * (rstd2 * fast_rcp(1.0f + fast_exp2(ga * nrl))); }
                u32x4 w; w.x = cvt_pk_bf16(a[0], a[1]); w.y = cvt_pk_bf16(a[2], a[3]); w.z = cvt_pk_bf16(a[4], a[5]); w.w = cvt_pk_bf16(a[6], a[7]);
                st_wt16(O + (size_t)(row - row_off) * ldo + col, w);
            }
    }
};
struct EpiMoeDown {
    static constexpr bool PERM = true, AFTER_DRAIN = false, SK = false;
    bf16_t* Yw; float sc; bf16_t* YP;
    __device__ __forceinline__ void operator()(const f32x4 (&acc)[2][2][4][2], const Unit& u, int wr, int wc, int fr, int fq) const {
        bf16_t* const Y = u.mode ? YP + ((long)(u.mode - 1) * MOE_TAIL_ROWS - (long)MOE_TAIL_ROW0) * DM : Yw;
        const int row0 = u.pm * BM + wr * 64 + fr, colb = (u.pn & 3) * BM + wc * 32 + 8 * fq;
#pragma unroll
        for (int ai = 0; ai < 2; ++ai)
#pragma unroll
            for (int m = 0; m < 4; ++m) {
                const int row = row0 + ai * HALF + m * 16;
#pragma unroll
                for (int bj = 0; bj < 2; ++bj) {
                    const f32x4 v0 = acc[ai][bj][m][0] * sc, v1 = acc[ai][bj][m][1] * sc;
                    u32x4 w; w.x = cvt_pk_bf16(v0[0], v0[1]); w.y = cvt_pk_bf16(v0[2], v0[3]); w.z = cvt_pk_bf16(v1[0], v1[1]); w.w = cvt_pk_bf16(v1[2], v1[3]);
                    *(u32x4*)(Y + (size_t)row * DM + colb + bj * HALF) = w;
                }
            }
    }
};
struct MoeOrder {
    int nM, nN, nwg, G, c, p0; const int* pexp;
    __device__ void init(int np, int nN_, int G_, int c_, int p0_, const int* pexp_) { nM = np; nN = nN_; nwg = nM * nN; G = G_; c = c_; p0 = p0_; pexp = pexp_; }
    __device__ bool next(int i, Unit& u) const {
        const long L = (long)i * G + c; if (L >= nwg) return false;
        int wgid = (int)L; { const int q = nwg / NXCD, r = nwg % NXCD, xcd = wgid % NXCD, off = wgid / NXCD; wgid = (xcd < r ? xcd * (q + 1) : r * (q + 1) + (xcd - r) * q) + off; }
        const int nig = WGM * nN, gid = wgid / nig, fm = gid * WGM, gsz = (nM - fm) < WGM ? (nM - fm) : WGM;
        const int pm = p0 + fm + ((wgid % nig) % gsz), pn = (wgid % nig) / gsz;
        u.pm = pm; u.pn = pexp[pm] * nN + pn; return true;
    }
    __device__ __forceinline__ void a_ready(const Unit&) const {}
    __device__ __forceinline__ void done(const Unit&) const {}
};

struct DenseMap { int nM, nN; __device__ __forceinline__ void map(int idx, Unit& u) const { const int nig = WGM * nN, gid = idx / nig, fm = gid * WGM, gsz = (nM - fm) < WGM ? (nM - fm) : WGM; u.pm = fm + ((idx % nig) % gsz); u.pn = (idx % nig) / gsz; } };
struct MoeMap { int nM, nN, p0; const int* pexp; __device__ __forceinline__ void map(int idx, Unit& u) const { const int nig = WGM * nN, gid = idx / nig, fm = gid * WGM, gsz = (nM - fm) < WGM ? (nM - fm) : WGM; const int pm = p0 + fm + ((idx % nig) % gsz); u.pm = pm; u.pn = pexp[pm] * nN + (idx % nig) / gsz; } };
constexpr int SK_TAB_OFF = LDSCTL_OFF + 1024, SK_TAB_MAX = 48;
template <class Map> __device__ __forceinline__ void sk_build(PG8_LAS int* tab, const Map& M, int U, int P, int G, int bid, float* part0, float* part1, int split, unsigned* flags, const bool leader_thread) {
    if (leader_thread) {
        int NX = 8, x = bid % 8, ci = bid / 8, ncx = G / 8; if (G % 8) { NX = 1; x = 0; ci = bid; ncx = G; }
        const int q = U / NX, r = U % NX, qx = q + (x < r ? 1 : 0), Sx = (x < r) ? x * (q + 1) : r * (q + 1) + (x - r) * q;
        int Rdp = q / ncx - 1; if (Rdp < 0) Rdp = 0;
        int n = 0;
#define SK_PUT(idx_, kb_, nk_, mode_, sl_) do { Unit u_; M.map((idx_), u_); PG8_LAS int* t_ = tab + 16 * n; t_[0] = u_.pm; t_[1] = u_.pn; t_[2] = (kb_); t_[3] = (nk_); t_[4] = (mode_); \
            const int s_ = (sl_); const unsigned long long sa_ = (unsigned long long)((s_ < split) ? part0 + (size_t)s_ * 65536 : part1 + (size_t)(s_ - split) * 65536), fa_ = (unsigned long long)(flags + s_ * 16); \
            t_[6] = (int)sa_; t_[7] = (int)(sa_ >> 32); t_[8] = (int)fa_; t_[9] = (int)(fa_ >> 32); ++n; } while (0)
        for (int i = 0; i < Rdp; ++i) SK_PUT(Sx + i * ncx + ci, 0, 0, 0, 0);
        const int remx = qx - Rdp * ncx, b0 = Sx + Rdp * ncx, TP = remx * P, base = TP / ncx, remn = TP % ncx;
        if (P <= 0 || base < P) {     for (int j = ci; j < remx && n < SK_TAB_MAX; j += ncx) SK_PUT(b0 + j, 0, 0, 0, 0); }
        else {
            const int s = ci * base + (ci < remn ? ci : remn), e = s + base + (ci < remn ? 1 : 0);
            const int u0 = s / P, p0 = s % P, u1 = e / P, p1 = e % P, first_full = p0 ? u0 + 1 : u0;
            if (p0) SK_PUT(b0 + u0, 2 * p0, 2 * (P - p0), 1, bid);
            for (int qq = first_full; qq < u1 && n < SK_TAB_MAX - 1; ++qq) SK_PUT(b0 + qq, 0, 0, 0, 0);
            if (p1) SK_PUT(b0 + u1, 0, 2 * p1, 2, bid + NX);
        }
#undef SK_PUT
        tab[-16] = n;
    }
    __syncthreads();
}
struct TabOrder {
    unsigned taddr;
    __device__ __forceinline__ explicit TabOrder(const PG8_LAS int* tab) : taddr((unsigned)__builtin_amdgcn_readfirstlane((int)(unsigned)(unsigned long long)(const void*)tab)) {}
    __device__ __forceinline__ bool next(int i, Unit& u) const {
        const PG8_LAS int* hdr = (const PG8_LAS int*)(unsigned long long)(taddr - 64u);
        if (i >= __builtin_amdgcn_readfirstlane(hdr[0])) return false;
        const PG8_LAS int* t = (const PG8_LAS int*)(unsigned long long)(taddr + 64u * (unsigned)i);
        u.pm = __builtin_amdgcn_readfirstlane(t[0]); u.pn = __builtin_amdgcn_readfirstlane(t[1]); u.kb = __builtin_amdgcn_readfirstlane(t[2]); u.nk = __builtin_amdgcn_readfirstlane(t[3]); u.mode = __builtin_amdgcn_readfirstlane(t[4]); u.slot = i; return true;
    }
    __device__ __forceinline__ void a_ready(const Unit&) const {}
    __device__ __forceinline__ void done(const Unit&) const {}
};
template <class Epi> struct EpiSK {
    static constexpr bool PERM = Epi::PERM, AFTER_DRAIN = false, SK = true;
    Epi E; unsigned taddr; unsigned* tmo;
    static __device__ __forceinline__ int tid_now(int wid) { int l_; asm volatile("v_mbcnt_lo_u32_b32 %0, -1, 0\n\tv_mbcnt_hi_u32_b32 %0, -1, %0" : "=v"(l_)); return wid * 64 + l_; }
    __device__ __forceinline__ void init_acc(f32x4 (&acc)[2][2][4][2], const Unit& u, int wid) const {
        if (u.mode != 2) {
#pragma unroll
            for (int a = 0; a < 2; ++a)
#pragma unroll
                for (int b = 0; b < 2; ++b)
#pragma unroll
                    for (int m = 0; m < 4; ++m)
#pragma unroll
                        for (int n = 0; n < 2; ++n) acc[a][b][m][n] = (f32x4){0.f, 0.f, 0.f, 0.f};
            return;
        }
        const int tid = tid_now(wid);
        const PG8_LAS int* t = (const PG8_LAS int*)(unsigned long long)(taddr + 64u * (unsigned)u.slot);
        const unsigned slo = (unsigned)__builtin_amdgcn_readfirstlane(t[6]), shi = (unsigned)__builtin_amdgcn_readfirstlane(t[7]), flo = (unsigned)__builtin_amdgcn_readfirstlane(t[8]), fhi = (unsigned)__builtin_amdgcn_readfirstlane(t[9]);
        const __amdgpu_buffer_rsrc_t rs = __builtin_amdgcn_make_buffer_rsrc((void*)(((unsigned long long)shi << 32) | slo), 0, 262144, 0x00020000);
        unsigned* fl = (unsigned*)(((unsigned long long)fhi << 32) | flo);
        { const unsigned long long t0 = __builtin_amdgcn_s_memrealtime();
          while ((unsigned)__builtin_amdgcn_readfirstlane((int)__hip_atomic_load(fl, __ATOMIC_RELAXED, __HIP_MEMORY_SCOPE_AGENT)) < 8u) {
              if (__builtin_amdgcn_s_memrealtime() - t0 > 2000000ull) { if ((tid & 63) == 0) __hip_atomic_store(tmo, 1u, __ATOMIC_RELAXED, __HIP_MEMORY_SCOPE_AGENT); break; }
              __builtin_amdgcn_s_sleep(2); } }
#pragma unroll
        for (int ai = 0; ai < 2; ++ai)
#pragma unroll
            for (int bj = 0; bj < 2; ++bj)
#pragma unroll
                for (int m = 0; m < 4; ++m)
#pragma unroll
                    for (int n = 0; n < 2; ++n) acc[ai][bj][m][n] = __builtin_bit_cast(f32x4, __builtin_amdgcn_raw_buffer_load_b128(rs, (unsigned)(tid * 16), ((((ai * 2 + bj) * 4 + m) * 2 + n) * 8192), 16));
        asm volatile("s_waitcnt vmcnt(0)" ::: "memory");
    }
    __device__ __forceinline__ void operator()(f32x4 (&acc)[2][2][4][2], const Unit& u, int wr, int wc, int fr, int fq) const {
        if (u.mode == 1) {
            const int tid = tid_now(wr * 4 + wc);
            const PG8_LAS int* t = (const PG8_LAS int*)(unsigned long long)(taddr + 64u * (unsigned)u.slot);
            const unsigned slo = (unsigned)__builtin_amdgcn_readfirstlane(t[6]), shi = (unsigned)__builtin_amdgcn_readfirstlane(t[7]), flo = (unsigned)__builtin_amdgcn_readfirstlane(t[8]), fhi = (unsigned)__builtin_amdgcn_readfirstlane(t[9]);
            const __amdgpu_buffer_rsrc_t rs = __builtin_amdgcn_make_buffer_rsrc((void*)(((unsigned long long)shi << 32) | slo), 0, 262144, 0x00020000);
            unsigned* fl = (unsigned*)(((unsigned long long)fhi << 32) | flo);
#pragma unroll
            for (int ai = 0; ai < 2; ++ai)
#pragma unroll
                for (int bj = 0; bj < 2; ++bj)
#pragma unroll
                    for (int m = 0; m < 4; ++m)
#pragma unroll
                        for (int n = 0; n < 2; ++n) __builtin_amdgcn_raw_buffer_store_b128(__builtin_bit_cast(u32x4, acc[ai][bj][m][n]), rs, (unsigned)(tid * 16), ((((ai * 2 + bj) * 4 + m) * 2 + n) * 8192), 16);
            asm volatile("s_waitcnt vmcnt(0)" ::: "memory");
            if ((tid & 63) == 0) __hip_atomic_fetch_add(fl, 1u, __ATOMIC_RELAXED, __HIP_MEMORY_SCOPE_AGENT);
            return;
        }
        E(acc, u, wr, wc, fr, fq);
    }
};
}

struct Frame {
    LAS unsigned char* lds;
    volatile LAS unsigned* MISC;
    gu32* ctl;
    int tid, lane, wave;
    int vcu, G;
    unsigned char* ws;
    const float* in[17];
    float* out;
};
enum { I_X = 0, I_MIXNORM, I_WIN, I_WGLR, I_BGLR, I_CONVW, I_GLANORM, I_WOUT, I_FFNNORM, I_DWG, I_DWU, I_DWD, I_ROUTER, I_EWG, I_EWU, I_EWD, I_FINALNORM };

__device__ __forceinline__ float* ss_arr(Frame& F, int k) { return (float*)(F.ws + WS_SSP) + (size_t)k * T * 16; }

__device__ __forceinline__ void rstd_cache_fill(Frame& F, const pg8::StaticOrder& S, const float* ss) {
    LAS float* rc = (LAS float*)(F.lds + RSTD_CACHE_OFF);
    pg8::Unit u;
    for (int i = (F.tid >> 8); i < RSTD_CACHE_MAX && S.next(i, u); i += 2) rc[i * 256 + (F.tid & 255)] = row_rstd(ss, u.pm * 256 + (F.tid & 255));
    __syncthreads();
}

__device__ __forceinline__ int dst_row(int mode, int n) {
    if (mode == 1) { if (n < 1024) { const int d = n & 63; return (n & ~63) + ((d < 32) ? 2 * d : 2 * (d - 32) + 1); } return n; }
    if (mode == 2) return (n >> 7) * 256 + (n & 127);
    if (mode == 3) return (n >> 7) * 256 + 128 + (n & 127);
    return n;
}
struct TJob { const float* W; const float* gain; bf16* WT; int K, N, nblk, mode, item; float f8scale; int pitch; };
__device__ __forceinline__ bool p0_job(Frame& F, int it, TJob& J) {
    constexpr int I_IN = 16 * 48, I_OUT = 16 * 16, I_DG = 16 * 44, I_DD = 44 * 16, I_EG = 16 * 56, I_EDN = 56 * 16;
    constexpr int NITEMS = 2 * I_IN + 2 * I_OUT + 2 * I_DG + I_DD + NEXP * (2 * I_EG + I_EDN);
    if (it >= NITEMS) return false;
    int r = NITEMS - 1 - it;
    if (r < 2 * I_IN) { const int l = r / I_IN; r -= l * I_IN; J = TJob{F.in[I_WIN] + (size_t)l * DM * INTOT, F.in[I_MIXNORM] + l * DM, (bf16*)(F.ws + WS_WIN) + (size_t)l * NPROJ * DM, DM, INTOT, 48, 1, r, 0.f, 0}; return true; } r -= 2 * I_IN;
    if (r < 2 * I_OUT) { const int l = r / I_OUT; r -= l * I_OUT; J = TJob{F.in[I_WOUT] + (size_t)l * DM * DM, nullptr, (bf16*)(F.ws + WS_WOUT) + (size_t)l * DM * DM, DM, DM, 16, 0, r, 0.f, 0}; return true; } r -= 2 * I_OUT;
    if (r < I_DG) { J = TJob{F.in[I_DWG], F.in[I_FFNNORM], (bf16*)(F.ws + WS_WGU), DM, FFD, 44, 2, r, 0.f, 0}; return true; } r -= I_DG;
    if (r < I_DG) { J = TJob{F.in[I_DWU], F.in[I_FFNNORM], (bf16*)(F.ws + WS_WGU), DM, FFD, 44, 3, r, 0.f, 0}; return true; } r -= I_DG;
    if (r < I_DD) { J = TJob{F.in[I_DWD], nullptr, (bf16*)(F.ws + WS_WD), FFD, DM, 16, 0, r, 0.f, FFD_PITCH}; return true; } r -= I_DD;
    const int e = r / (2 * I_EG + I_EDN); r -= e * (2 * I_EG + I_EDN);
    if (r < I_EG) { J = TJob{F.in[I_EWG] + (size_t)e * DM * FFE, F.in[I_FFNNORM] + DM, (bf16*)(F.ws + WS_EGU + (size_t)e * 2 * FFE * DM), DM, FFE, 56, 2, r, W8_UP, 0}; return true; } r -= I_EG;
    if (r < I_EG) { J = TJob{F.in[I_EWU] + (size_t)e * DM * FFE, F.in[I_FFNNORM] + DM, (bf16*)(F.ws + WS_EGU + (size_t)e * 2 * FFE * DM), DM, FFE, 56, 3, r, W8_UP, 0}; return true; } r -= I_EG;
    J = TJob{F.in[I_EWD] + (size_t)e * FFE * DM, nullptr, (bf16*)(F.ws + WS_ED + (size_t)e * DM * FFE_PITCH), FFE, DM, 16, 0, r, W8_DN, FFE_PITCH}; return true;
}
__device__ __forceinline__ void t64_load(const TJob& J, int lane, f32x4 (&v)[16]) {
    const int kb = J.item / J.nblk, nb = J.item % J.nblk;
    const float* src = J.W + (size_t)(64 * kb + (lane >> 4)) * J.N + 64 * nb + 4 * (lane & 15);
#pragma unroll
    for (int i = 0; i < 16; ++i) v[i] = __builtin_nontemporal_load((const f32x4*)(src + (size_t)(4 * i) * J.N));
}
__device__ __forceinline__ void t64_finish(const TJob& J, int lane, const f32x4 (&v)[16], LAS float* scr) {
    const int kb = J.item / J.nblk, nb = J.item % J.nblk, k0 = 64 * kb, n0 = 64 * nb;
#pragma unroll
    for (int i = 0; i < 16; ++i) { LAS float* d = scr + (4 * i + (lane >> 4)) * 65 + 4 * (lane & 15); d[0] = v[i][0]; d[1] = v[i][1]; d[2] = v[i][2]; d[3] = v[i][3]; }
    LDS_WAIT(); asm volatile("" ::: "memory");
    const int c = lane & 7;
    float g[8];
#pragma unroll
    for (int i = 0; i < 8; ++i) g[i] = J.gain ? J.gain[k0 + 8 * c + i] : 1.0f;
    if (J.f8scale != 0.f) {
#pragma unroll
        for (int i = 0; i < 8; ++i) g[i] *= J.f8scale;
        unsigned char* W8 = (unsigned char*)J.WT;
#pragma unroll
        for (int j = 0; j < 8; ++j) { const int n = (lane >> 3) + 8 * j; const LAS float* s = scr + (8 * c) * 65 + n;
            unsigned long long o = (unsigned long long)pg8::pk4_fp8(s[0 * 65] * g[0], s[1 * 65] * g[1], s[2 * 65] * g[2], s[3 * 65] * g[3]) | ((unsigned long long)pg8::pk4_fp8(s[4 * 65] * g[4], s[5 * 65] * g[5], s[6 * 65] * g[6], s[7 * 65] * g[7]) << 32);
            *(GAS unsigned long long*)(W8 + (size_t)dst_row(J.mode, n0 + n) * (J.pitch ? J.pitch : J.K) + k0 + 8 * c) = o; }
    } else {
#pragma unroll
    for (int j = 0; j < 8; ++j) { const int n = (lane >> 3) + 8 * j; const LAS float* s = scr + (8 * c) * 65 + n;
        v4u o; o.x = pk2(s[0 * 65] * g[0], s[1 * 65] * g[1]); o.y = pk2(s[2 * 65] * g[2], s[3 * 65] * g[3]); o.z = pk2(s[4 * 65] * g[4], s[5 * 65] * g[5]); o.w = pk2(s[6 * 65] * g[6], s[7 * 65] * g[7]);
        *(GAS v4u*)(J.WT + (size_t)dst_row(J.mode, n0 + n) * (J.pitch ? J.pitch : J.K) + k0 + 8 * c) = o; }
    }
    LDS_WAIT(); asm volatile("" ::: "memory");
}
__device__ __forceinline__ void p0_prologue(Frame& F) {
    LAS float* scr = (LAS float*)(F.lds + RING_OFF + F.wave * 16640);
    const int gw = F.vcu * NWAVES + F.wave, NGW = F.G * NWAVES, lane = F.lane;
    {
        TJob J, Jn; f32x4 v[16], vn[16];
        int it = gw; bool have = p0_job(F, it, J);
        if (have) t64_load(J, lane, v);
        while (have) {
            const bool hn = p0_job(F, it + NGW, Jn);
            if (hn) t64_load(Jn, lane, vn);
            t64_finish(J, lane, v, scr);
            if (!hn) break;
            J = Jn; it += NGW;
#pragma unroll
            for (int i = 0; i < 16; ++i) v[i] = vn[i];
        }
    }
    {
        float* ss0 = ss_arr(F, 0); bf16* HB = (bf16*)(F.ws + WS_HB);
        for (int m0 = gw; m0 < T; m0 += 2 * NGW) {
            f32x4 v[2][4];
#pragma unroll
            for (int k = 0; k < 2; ++k) { const int m = (m0 + k * NGW < T) ? m0 + k * NGW : m0; const GAS f32x4* xr = (const GAS f32x4*)(F.in[I_X] + (size_t)m * DM) + lane;
#pragma unroll
                for (int j = 0; j < 4; ++j) v[k][j] = __builtin_nontemporal_load(xr + 64 * j); }
            asm volatile("" : "+v"(v[0][0]), "+v"(v[0][1]), "+v"(v[0][2]), "+v"(v[0][3]), "+v"(v[1][0]), "+v"(v[1][1]), "+v"(v[1][2]), "+v"(v[1][3]));
#pragma unroll
            for (int k = 0; k < 2; ++k) { const int m = m0 + k * NGW; if (m >= T) break;
                float s = 0.f;
#pragma unroll
                for (int j = 0; j < 4; ++j) { const unsigned p0_ = pk2(v[k][j].x, v[k][j].y), p1_ = pk2(v[k][j].z, v[k][j].w); const float a0 = bflo(p0_), a1 = bfhi(p0_), a2 = bflo(p1_), a3 = bfhi(p1_); s += (a0 * a0 + a1 * a1) + (a2 * a2 + a3 * a3); }
                s = wave_sum(s);
                GAS unsigned long long* o8 = (GAS unsigned long long*)(HB + (size_t)m * DM) + lane;
#pragma unroll
                for (int j = 0; j < 4; ++j) o8[64 * j] = (unsigned long long)pk2(v[k][j].x, v[k][j].y) | ((unsigned long long)pk2(v[k][j].z, v[k][j].w) << 32);
                if (lane < 16) ss0[(size_t)m * 16 + lane] = (lane == 0) ? s : 0.f; }
        }
    }
    const int gt = F.vcu * (NWAVES * 64) + F.tid, NGT = F.G * NWAVES * 64;
    for (int i = gt; i < 2 * 16 * DM; i += NGT) { const int l = i / (16 * DM), r = (i / DM) & 15, k = i & (DM - 1);
        ((bf16*)(F.ws + WS_WGZ))[i] = (bf16)f2bf(F.in[I_WIN][(size_t)l * DM * INTOT + (size_t)k * INTOT + NPROJ + r] * F.in[I_MIXNORM][l * DM + k]); }
    for (int i = gt; i < 16 * DM; i += NGT) { const int e = i >> 10, k = i & (DM - 1); const float v = (e < NEXP) ? F.in[I_ROUTER][k * NEXP + e] * F.in[I_FFNNORM][DM + k] : 0.f;
        const unsigned hb_ = f2bf(v); const float vh = __uint_as_float(hb_ << 16); ((bf16*)(F.ws + WS_RG))[i] = (bf16)hb_; ((bf16*)(F.ws + WS_RG))[16 * DM + i] = (bf16)f2bf(v - vh); }
    for (int i = gt; i < SEQ * 32; i += NGT) { const int pos = i >> 5, fi = i & 31;
        const float inv = 1.0f / powf(10000.0f, (float)(2 * fi) / 64.0f);
        const float ang = (float)pos * inv;
        const double rev = (double)ang * 0.15915494309189535; const double fr = rev - rint(rev);
        const float f = (float)fr;
        float* o = (float*)(F.ws + WS_ROPE) + (size_t)i * 2; o[0] = __builtin_amdgcn_cosf(f); o[1] = __builtin_amdgcn_sinf(f); }
}

__device__ __forceinline__ void gz_phase(Frame& F, const bf16* HB, const bf16* WGZ, const float* ss, float* GZ) {
    const int lane = F.lane, kh = F.wave >> 2;
    LAS f32x4* xch = (LAS f32x4*)(F.lds + RING_OFF) + (F.wave & 3) * 64 + lane;
    __syncthreads();
    for (int bt = F.vcu * 4; bt < T / 16; bt += F.G * 4) {
        const int task = bt + (F.wave & 3), t0 = task * 16; const bool live = task < T / 16;
        f32x4 acc = (f32x4){0.f, 0.f, 0.f, 0.f};
        if (live) {
            const bf16* ap = WGZ + (size_t)(lane & 15) * DM + 8 * (lane >> 4) + 512 * kh;
            const bf16* bp = HB + (size_t)(t0 + (lane & 15)) * DM + 8 * (lane >> 4) + 512 * kh;
            bf16x8 a[16], b[16];
#pragma unroll
            for (int q = 0; q < 16; ++q) { a[q] = *(const bf16x8*)(ap + 32 * q); b[q] = *(const bf16x8*)(bp + 32 * q); }
            asm volatile("" : "+v"(a[0]), "+v"(a[1]), "+v"(a[2]), "+v"(a[3]), "+v"(a[4]), "+v"(a[5]), "+v"(a[6]), "+v"(a[7]), "+v"(a[8]), "+v"(a[9]), "+v"(a[10]), "+v"(a[11]), "+v"(a[12]), "+v"(a[13]), "+v"(a[14]), "+v"(a[15]) :: "memory");
            asm volatile("" : "+v"(b[0]), "+v"(b[1]), "+v"(b[2]), "+v"(b[3]), "+v"(b[4]), "+v"(b[5]), "+v"(b[6]), "+v"(b[7]), "+v"(b[8]), "+v"(b[9]), "+v"(b[10]), "+v"(b[11]), "+v"(b[12]), "+v"(b[13]), "+v"(b[14]), "+v"(b[15]) :: "memory");
#pragma unroll
            for (int q = 0; q < 16; ++q) acc = __builtin_amdgcn_mfma_f32_16x16x32_bf16(a[q], b[q], acc, 0, 0, 0);
        }
        if (kh) *xch = acc;
        __syncthreads();
        if (!kh && live) {
            acc += *xch;
            const int tok = t0 + (lane & 15);
            const float rstd = row_rstd(ss, tok);
            st_wt16(GZ + (size_t)tok * 16 + 4 * (lane >> 4), acc * rstd);
        }
        __syncthreads();
    }
}

__device__ __forceinline__ void conv_phase(int gt, int NGT, const bf16* PROJ, const float* cw, bf16* MIX) {
    for (int i = gt; i < (T / 4) * 32; i += NGT) {
        const int t0 = (i >> 5) * 4, c0 = (i & 31) * 8, tp0 = t0 & (SEQ - 1);
        v4u cc[6], ch[6], cb[4]; f32x4 w0[3], w1[3];
#pragma unroll
        for (int q = 0; q < 6; ++q) { const int tt = (tp0 - 2 + q >= 0) ? t0 - 2 + q : t0; cc[q] = *(const v4u*)(PROJ + (size_t)tt * NPROJ + PC_CC + c0); ch[q] = *(const v4u*)(PROJ + (size_t)tt * NPROJ + PC_CH + c0); }
#pragma unroll
        for (int q = 0; q < 4; ++q) cb[q] = *(const v4u*)(PROJ + (size_t)(t0 + q) * NPROJ + PC_CB + c0);
#pragma unroll
        for (int j = 0; j < 3; ++j) { w0[j] = *(const f32x4*)(cw + j * 256 + c0); w1[j] = *(const f32x4*)(cw + j * 256 + c0 + 4); }
        asm volatile("" : "+v"(cc[0]), "+v"(cc[1]), "+v"(cc[2]), "+v"(cc[3]), "+v"(cc[4]), "+v"(cc[5]), "+v"(ch[0]), "+v"(ch[1]), "+v"(ch[2]), "+v"(ch[3]), "+v"(ch[4]), "+v"(ch[5]),
                     "+v"(cb[0]), "+v"(cb[1]), "+v"(cb[2]), "+v"(cb[3]), "+v"(w0[0]), "+v"(w0[1]), "+v"(w0[2]), "+v"(w1[0]), "+v"(w1[1]), "+v"(w1[2]));
        float p[6][8];
#pragma unroll
        for (int q = 0; q < 6; ++q) { const float ok = (tp0 - 2 + q >= 0) ? 1.f : 0.f;
            p[q][0] = ok * bflo(cc[q].x) * bflo(ch[q].x); p[q][1] = ok * bfhi(cc[q].x) * bfhi(ch[q].x); p[q][2] = ok * bflo(cc[q].y) * bflo(ch[q].y); p[q][3] = ok * bfhi(cc[q].y) * bfhi(ch[q].y);
            p[q][4] = ok * bflo(cc[q].z) * bflo(ch[q].z); p[q][5] = ok * bfhi(cc[q].z) * bfhi(ch[q].z); p[q][6] = ok * bflo(cc[q].w) * bflo(ch[q].w); p[q][7] = ok * bfhi(cc[q].w) * bfhi(ch[q].w); }
#pragma unroll
        for (int q = 0; q < 4; ++q) {
            float y[8];
#pragma unroll
            for (int e = 0; e < 8; ++e) { y[e] = 0.f;
#pragma unroll
                for (int j = 0; j < 3; ++j) y[e] += (e < 4 ? w0[j][e & 3] : w1[j][e & 3]) * p[q + j][e]; }
            const v4u b = cb[q];
            v4u o; o.x = pk2(y[0] * bflo(b.x), y[1] * bfhi(b.x)); o.y = pk2(y[2] * bflo(b.y), y[3] * bfhi(b.y)); o.z = pk2(y[4] * bflo(b.z), y[5] * bfhi(b.z)); o.w = pk2(y[6] * bflo(b.w), y[7] * bfhi(b.w));
            *(v4u*)(MIX + (size_t)(t0 + q) * DM + 512 + c0) = o;
        }
    }
}

typedef float f32x16 __attribute__((ext_vector_type(16)));
typedef short v4i16_t __attribute__((ext_vector_type(4)));
constexpr int A2_KROW = 144, A2_VROW = 192, A2_ROWS = 384, A2_K_OFF = 0, A2_V_OFF = A2_ROWS * A2_KROW;
static_assert(A2_V_OFF + A2_ROWS * A2_VROW <= RING_BYTES, "attention LDS");
constexpr int A2_UNITS = 3 * NB * 8 * 32;
constexpr size_t WS_OPART = WS_DYN + 134 * MiB;
constexpr size_t WS_LSE = WS_DYN + 182 * MiB;
__device__ __forceinline__ float xmax32(float x) { const auto r = __builtin_amdgcn_permlane32_swap(__float_as_uint(x), __float_as_uint(x), false, false); return fmaxf(__uint_as_float(r[0]), __uint_as_float(r[1])); }
__device__ __forceinline__ float xsum32(float x) { const auto r = __builtin_amdgcn_permlane32_swap(__float_as_uint(x), __float_as_uint(x), false, false); return __uint_as_float(r[0]) + __uint_as_float(r[1]); }
__device__ __forceinline__ bf16x8 pack8(float a0, float a1, float a2, float a3, float a4, float a5, float a6, float a7) {
    v4u w; w.x = pg8::cvt_pk_bf16(a0, a1); w.y = pg8::cvt_pk_bf16(a2, a3); w.z = pg8::cvt_pk_bf16(a4, a5); w.w = pg8::cvt_pk_bf16(a6, a7); return __builtin_bit_cast(bf16x8, w); }
__device__ __forceinline__ bf16x8 tr8(const LAS unsigned char* p0, const LAS unsigned char* p1) {
    const v4i16_t a = __builtin_amdgcn_ds_read_tr16_b64_v4i16((LAS v4i16_t*)p0), b = __builtin_amdgcn_ds_read_tr16_b64_v4i16((LAS v4i16_t*)p1);
    return (bf16x8){a[0], a[1], a[2], a[3], b[0], b[1], b[2], b[3]}; }
struct A2Unit { int dli, dl, b, h, r, P0, L; };
__device__ __forceinline__ void a2_decode(int unit, int rot, A2Unit& u) {
    u.dli = unit >> 9; const int rem = unit & 511; u.b = rem >> 8; u.h = (rem >> 5) & 7; const int j = (rem + rot) & 31;
    u.dl = (u.dli == 0) ? 1 : (u.dli == 1) ? 4 : 16; const int sh = (u.dli == 0) ? 5 : (u.dli == 1) ? 3 : 1;
    u.r = j >> sh; u.P0 = (j & ((1 << sh) - 1)) * 256; u.L = SEQ / u.dl;
}
__device__ __forceinline__ void a2_issue(const bf16* PROJ, const A2Unit& u, int tid, int w, int lane, v4u (&kk)[6], v4u (&vv)[6], bf16x8 (&qf)[4]) {
#pragma unroll
    for (int i = 0; i < 6; ++i) { const int c = tid + 512 * i, row = c >> 3, c16 = c & 7; int p = u.P0 - 128 + row; p = p < 0 ? 0 : (p >= u.L ? u.L - 1 : p);
        const bf16* src = PROJ + (size_t)(u.b * SEQ + p * u.dl + u.r) * NPROJ + u.h * 64 + c16 * 8;
        kk[i] = *(const v4u*)(src + PC_K); vv[i] = *(const v4u*)(src + PC_V); }
    const int pq = u.P0 + 32 * w + (lane & 31);
    const bf16* qp = PROJ + (size_t)(u.b * SEQ + pq * u.dl + u.r) * NPROJ + PC_Q + u.h * 64 + 8 * (lane >> 5);
#pragma unroll
    for (int s = 0; s < 4; ++s) qf[s] = *(const bf16x8*)(qp + 16 * s);
}
__device__ __forceinline__ void a2_stage(LAS unsigned char* lds, int tid, const v4u (&kk)[6], const v4u (&vv)[6]) {
#pragma unroll
    for (int i = 0; i < 6; ++i) { const int c = tid + 512 * i, row = c >> 3, c16 = c & 7;
        *(LAS v4u*)(lds + A2_K_OFF + row * A2_KROW + c16 * 16) = kk[i]; *(LAS v4u*)(lds + A2_V_OFF + row * A2_VROW + c16 * 16) = vv[i]; }
}
__device__ __forceinline__ void a2_compute(const LAS unsigned char* lds, const A2Unit& u, int w, int lane, const bf16x8 (&qf)[4], bf16* OPART, float* LSE) {
    const int r32 = lane & 31, hi = lane >> 5;
    const int pq = u.P0 + 32 * w + r32;
    f32x16 o[2]; o[0] = (f32x16){}; o[1] = (f32x16){}; float m = -1e30f, l = 0.f;
    const LAS unsigned char* kb = lds + A2_K_OFF + (32 * w + r32) * A2_KROW + 16 * hi;
    const LAS unsigned char* trb = lds + A2_V_OFF + (32 * w + 4 * hi + ((lane & 15) >> 2)) * A2_VROW + (16 * ((lane >> 4) & 1) + 4 * (lane & 3)) * 2;
#pragma unroll
    for (int kt = 0; kt < 5; ++kt) {
        const int pkb = u.P0 - 128 + 32 * w + 32 * kt;
        if (pkb + 31 < 0) continue;
        f32x16 st = {};
#pragma unroll
        for (int s = 0; s < 4; ++s) { const bf16x8 kf = *(const LAS bf16x8*)(kb + kt * 32 * A2_KROW + 32 * s); st = __builtin_amdgcn_mfma_f32_32x32x16_bf16(kf, qf[s], st, 0, 0, 0); }
        float tmax = -1e30f;
        if (pkb < 0) {
#pragma unroll
            for (int r = 0; r < 16; ++r) { const int pk = pkb + (r & 3) + 8 * (r >> 2) + 4 * hi; const int df = pq - pk;
                const bool ok = pk >= 0 && df >= 0 && df <= 128; st[r] = ok ? st[r] : -1e30f; }
        } else if (kt == 0) {
            const int dd = r32 - 4 * hi;
#pragma unroll
            for (int r = 0; r < 16; ++r) st[r] = ((r & 3) + 8 * (r >> 2) >= dd) ? st[r] : -1e30f;
        } else if (kt == 4) {
            const int dd = r32 - 4 * hi;
#pragma unroll
            for (int r = 0; r < 16; ++r) st[r] = ((r & 3) + 8 * (r >> 2) <= dd) ? st[r] : -1e30f;
        }
#pragma unroll
        for (int r = 0; r < 16; ++r) tmax = fmaxf(tmax, st[r]);
        tmax = xmax32(tmax);
        const float mn = fmaxf(m, tmax), alpha = fast_exp2(m - mn); m = mn;
        float ps = 0.f;
#pragma unroll
        for (int r = 0; r < 16; ++r) { st[r] = fast_exp2(st[r] - mn); ps += st[r]; }
        l = l * alpha + ps;
        o[0] *= alpha; o[1] *= alpha;
        const bf16x8 p0 = pack8(st[0], st[1], st[2], st[3], st[4], st[5], st[6], st[7]), p1 = pack8(st[8], st[9], st[10], st[11], st[12], st[13], st[14], st[15]);
        const LAS unsigned char* tb = trb + kt * 32 * A2_VROW;
#pragma unroll
        for (int vt = 0; vt < 2; ++vt) {
            const bf16x8 a0 = tr8(tb + vt * 64, tb + vt * 64 + 8 * A2_VROW), a1 = tr8(tb + vt * 64 + 16 * A2_VROW, tb + vt * 64 + 24 * A2_VROW);
            o[vt] = __builtin_amdgcn_mfma_f32_32x32x16_bf16(a0, p0, o[vt], 0, 0, 0);
            o[vt] = __builtin_amdgcn_mfma_f32_32x32x16_bf16(a1, p1, o[vt], 0, 0, 0);
        }
    }
    const float lt = xsum32(l), rl = 1.0f / lt;
    const size_t tok = (size_t)u.b * SEQ + (size_t)pq * u.dl + u.r;
    bf16* op = OPART + ((size_t)u.dli * T + tok) * 512 + u.h * 64 + 4 * hi;
#pragma unroll
    for (int vt = 0; vt < 2; ++vt)
#pragma unroll
        for (int g = 0; g < 4; ++g) { const unsigned long long wv = (unsigned long long)pg8::cvt_pk_bf16(o[vt][4 * g] * rl, o[vt][4 * g + 1] * rl) | ((unsigned long long)pg8::cvt_pk_bf16(o[vt][4 * g + 2] * rl, o[vt][4 * g + 3] * rl) << 32);
            *(unsigned long long*)(op + 32 * vt + 8 * g) = wv; }
    if (hi == 0) LSE[((size_t)u.dli * T + tok) * 8 + u.h] = m + __builtin_amdgcn_logf(lt);
}
__device__ __forceinline__ void attn_phase(Frame& F, const bf16* PROJ, const int unit0, const int ustride, const float* convw, bf16* MIX) {
    LAS unsigned char* lds = F.lds + RING_OFF;
    bf16* OPART = (bf16*)(F.ws + WS_OPART); float* LSE = (float*)(F.ws + WS_LSE);
    const int lane = F.lane, w = F.wave, tid = F.tid;
    int unit = unit0;
    if (unit >= A2_UNITS) { conv_phase(unit0 * (NWAVES * 64) + tid, ustride * (NWAVES * 64), PROJ, convw, MIX); return; }
    v4u kk[6], vv[6]; bf16x8 qn[4], qf[4]; A2Unit u, un;
    const bool rotate = (ustride & 31) == 0;
    a2_decode(unit, 0, u);
    a2_issue(PROJ, u, tid, w, lane, kk, vv, qn);
    conv_phase(unit0 * (NWAVES * 64) + tid, ustride * (NWAVES * 64), PROJ, convw, MIX);
    __syncthreads();
    for (;;) {
        a2_stage(lds, tid, kk, vv);
#pragma unroll
        for (int s = 0; s < 4; ++s) qf[s] = qn[s];
        const int nxt = unit + ustride; const bool has_next = nxt < A2_UNITS;
        __syncthreads();
        if (has_next) { a2_decode(nxt, rotate ? 5 * (nxt / ustride) : 0, un); a2_issue(PROJ, un, tid, w, lane, kk, vv, qn); }
        a2_compute(lds, u, w, lane, qf, OPART, LSE);
        if (PROBE_REP == 777) a2_compute(lds, u, w, lane, qf, OPART, LSE);
        if (!has_next) break;
        __syncthreads();
        unit = nxt; u = un;
    }
    __syncthreads();
}
__device__ __forceinline__ void attn_merge(Frame& F, int gt, int NGT, bf16* MIX) {
    const bf16* OPART = (const bf16*)(F.ws + WS_OPART); const float* LSE = (const float*)(F.ws + WS_LSE);
    for (int i0 = gt; i0 < T * 64; i0 += 2 * NGT) {
        float ls[2][3]; v4u ov[2][3];
#pragma unroll
        for (int k = 0; k < 2; ++k) { const int i = (i0 + k * NGT < T * 64) ? i0 + k * NGT : i0, tok = i >> 6, c = i & 63, h = c >> 3;
#pragma unroll
            for (int d = 0; d < 3; ++d) { ls[k][d] = LSE[((size_t)d * T + tok) * 8 + h]; ov[k][d] = __builtin_nontemporal_load((const v4u*)(OPART + ((size_t)d * T + tok) * 512 + c * 8)); } }
        asm volatile("" : "+v"(ls[0][0]), "+v"(ls[0][1]), "+v"(ls[0][2]), "+v"(ls[1][0]), "+v"(ls[1][1]), "+v"(ls[1][2]), "+v"(ov[0][0]), "+v"(ov[0][1]), "+v"(ov[0][2]), "+v"(ov[1][0]), "+v"(ov[1][1]), "+v"(ov[1][2]));
#pragma unroll
        for (int k = 0; k < 2; ++k) { const int i = i0 + k * NGT; if (i >= T * 64) break; const int tok = i >> 6, c = i & 63;
            const float l0 = ls[k][0], l1 = ls[k][1], l2 = ls[k][2];
            const float M = fmaxf(l0, fmaxf(l1, l2)); float w0 = fast_exp2(l0 - M), w1 = fast_exp2(l1 - M), w2 = fast_exp2(l2 - M); const float rs = 1.0f / (w0 + w1 + w2); w0 *= rs; w1 *= rs; w2 *= rs;
            const v4u a = ov[k][0], b = ov[k][1], d = ov[k][2];
            v4u o;
            o.x = pk2(w0 * bflo(a.x) + w1 * bflo(b.x) + w2 * bflo(d.x), w0 * bfhi(a.x) + w1 * bfhi(b.x) + w2 * bfhi(d.x));
            o.y = pk2(w0 * bflo(a.y) + w1 * bflo(b.y) + w2 * bflo(d.y), w0 * bfhi(a.y) + w1 * bfhi(b.y) + w2 * bfhi(d.y));
            o.z = pk2(w0 * bflo(a.z) + w1 * bflo(b.z) + w2 * bflo(d.z), w0 * bfhi(a.z) + w1 * bfhi(b.z) + w2 * bfhi(d.z));
            o.w = pk2(w0 * bflo(a.w) + w1 * bflo(b.w) + w2 * bflo(d.w), w0 * bfhi(a.w) + w1 * bfhi(b.w) + w2 * bfhi(d.w));
            *(v4u*)(MIX + (size_t)tok * DM + c * 8) = o;
        }
    }
}


__device__ __forceinline__ void attn_merge_rows(Frame& F, int row0, int nrows, bf16* MIX) {
    const bf16* OPART = (const bf16*)(F.ws + WS_OPART); const float* LSE = (const float*)(F.ws + WS_LSE);
    const int NI = nrows * 64, NT = NWAVES * 64;
    for (int i0 = F.tid; i0 < NI; i0 += 2 * NT) {
        float ls[2][3]; v4u ov[2][3];
#pragma unroll
        for (int k = 0; k < 2; ++k) { const int i = (i0 + k * NT < NI) ? i0 + k * NT : i0, tok = row0 + (i >> 6), c = i & 63, h = c >> 3;
#pragma unroll
            for (int d = 0; d < 3; ++d) { ls[k][d] = LSE[((size_t)d * T + tok) * 8 + h]; ov[k][d] = __builtin_nontemporal_load((const v4u*)(OPART + ((size_t)d * T + tok) * 512 + c * 8)); } }
        asm volatile("" : "+v"(ls[0][0]), "+v"(ls[0][1]), "+v"(ls[0][2]), "+v"(ls[1][0]), "+v"(ls[1][1]), "+v"(ls[1][2]), "+v"(ov[0][0]), "+v"(ov[0][1]), "+v"(ov[0][2]), "+v"(ov[1][0]), "+v"(ov[1][1]), "+v"(ov[1][2]));
#pragma unroll
        for (int k = 0; k < 2; ++k) { const int i = i0 + k * NT; if (i >= NI) break; const int tok = row0 + (i >> 6), c = i & 63;
            const float l0 = ls[k][0], l1 = ls[k][1], l2 = ls[k][2];
            const float M = fmaxf(l0, fmaxf(l1, l2)); float w0 = fast_exp2(l0 - M), w1 = fast_exp2(l1 - M), w2 = fast_exp2(l2 - M); const float rs = 1.0f / (w0 + w1 + w2); w0 *= rs; w1 *= rs; w2 *= rs;
            const v4u a = ov[k][0], b = ov[k][1], d = ov[k][2];
            v4u o;
            o.x = pk2(w0 * bflo(a.x) + w1 * bflo(b.x) + w2 * bflo(d.x), w0 * bfhi(a.x) + w1 * bfhi(b.x) + w2 * bfhi(d.x));
            o.y = pk2(w0 * bflo(a.y) + w1 * bflo(b.y) + w2 * bflo(d.y), w0 * bfhi(a.y) + w1 * bfhi(b.y) + w2 * bfhi(d.y));
            o.z = pk2(w0 * bflo(a.z) + w1 * bflo(b.z) + w2 * bflo(d.z), w0 * bfhi(a.z) + w1 * bfhi(b.z) + w2 * bfhi(d.z));
            o.w = pk2(w0 * bflo(a.w) + w1 * bflo(b.w) + w2 * bflo(d.w), w0 * bfhi(a.w) + w1 * bfhi(b.w) + w2 * bfhi(d.w));
            st_wt16(MIX + (size_t)tok * DM + c * 8, o);
        }
    }
}

constexpr int GLA_SEG = 4, GLA_NSEG = SEQ / (32 * GLA_SEG);
constexpr int GLA_AGG_STRIDE = 2048 + 32;
constexpr int GL_Q = 0, GL_K = 2048, GL_V = 4096, GL_EB = 4096 + 6144, GL_WAVE_BYTES = 10496;
static_assert(8 * GL_WAVE_BYTES <= RING_BYTES, "gla LDS");
constexpr size_t WS_GLAAGG = WS_DYN + 128 * MiB;
constexpr size_t WS_GLASST = WS_DYN + 184 * MiB;

__device__ __forceinline__ void st_dev(float* p, float v) { __hip_atomic_store(p, v, __ATOMIC_RELAXED, __HIP_MEMORY_SCOPE_AGENT); }
__device__ __forceinline__ float ld_dev(const float* p) { return __hip_atomic_load(p, __ATOMIC_RELAXED, __HIP_MEMORY_SCOPE_AGENT); }
__device__ __forceinline__ void st_devi(int* p, int v) { __hip_atomic_store(p, v, __ATOMIC_RELAXED, __HIP_MEMORY_SCOPE_AGENT); }
struct GlaCtx { const bf16* PROJ; const float* GZ; const float* wglr; const float* bglr; const float* gnorm; bf16* MIX; float* AGG; const float* SST; };

__device__ __forceinline__ float gla_prep_chunk(const GlaCtx& C, int h, size_t row0, const float (&W)[8], float bias, LAS unsigned char* L, int lane) {
    const int kf = lane & 31, hi = lane >> 5;
    v4u vv[4];
#pragma unroll
    for (int i = 0; i < 4; ++i) vv[i] = *(const v4u*)(C.PROJ + (row0 + (lane >> 3) + 8 * i) * NPROJ + PC_GV + h * 64 + (lane & 7) * 8);
    f32x4 gr[4];
#pragma unroll
    for (int i = 0; i < 4; ++i) gr[i] = *(const f32x4*)(C.GZ + (row0 + kf) * 16 + 4 * i);
    v4u qraw[2], kraw[2];
#pragma unroll
    for (int i = 0; i < 2; ++i) { const int c = lane + 64 * i; const bf16* src = C.PROJ + (row0 + (c >> 2)) * NPROJ + h * 32 + (c & 3) * 8; qraw[i] = *(const v4u*)(src + PC_GQ); kraw[i] = *(const v4u*)(src + PC_GK); }
    asm volatile("" : "+v"(vv[0]), "+v"(vv[1]), "+v"(vv[2]), "+v"(vv[3]), "+v"(gr[0]), "+v"(gr[1]), "+v"(gr[2]), "+v"(gr[3]), "+v"(qraw[0]), "+v"(qraw[1]), "+v"(kraw[0]), "+v"(kraw[1]));
#pragma unroll
    for (int i = 0; i < 2; ++i) { const int c = lane + 64 * i; *(LAS v4u*)(L + GL_Q + (c >> 2) * 64 + (c & 3) * 16) = qraw[i]; *(LAS v4u*)(L + GL_K + (c >> 2) * 64 + (c & 3) * 16) = kraw[i]; }
#pragma unroll
    for (int i = 0; i < 4; ++i) *(LAS v4u*)(L + GL_V + ((lane >> 3) + 8 * i) * 192 + (lane & 7) * 16) = vv[i];
    f32x16 z = {};
#pragma unroll
    for (int s = 0; s < 8; ++s) { const float a = hi ? gr[s >> 1][2 * (s & 1) + 1] : gr[s >> 1][2 * (s & 1)]; z = __builtin_amdgcn_mfma_f32_32x32x2f32(a, W[s], z, 0, 0, 0); }
    float bc[16], sg[4];
#pragma unroll
    for (int g4 = 0; g4 < 4; ++g4) { float run = 0.f;
#pragma unroll
        for (int e = 0; e < 4; ++e) { const float zz = z[4 * g4 + e] + bias;
            const float ls = fminf(zz, 0.f) - 0.6931471805599453f * __builtin_amdgcn_logf(1.0f + fast_exp2(-fabsf(zz) * LOG2E));
            run += ls * (1.0f / 16.0f); bc[4 * g4 + e] = run; }
        sg[g4] = run; }
    float off = 0.f, tot;
#pragma unroll
    for (int g4 = 0; g4 < 4; ++g4) { const float pg = __shfl_xor(sg[g4], 32); const float o_here = off + (hi ? pg : 0.f);
#pragma unroll
        for (int e = 0; e < 4; ++e) bc[4 * g4 + e] += o_here;
        off += sg[g4] + pg; }
    tot = off;
    const float qscale = 0.17677669529663687f;
    asm volatile("s_waitcnt lgkmcnt(0)" ::: "memory");
#pragma unroll
    for (int r = 0; r < 16; ++r) { const int t = (r & 3) + 8 * (r >> 2) + 4 * hi; const float e = fast_exp2(bc[r] * LOG2E), ei = fast_exp2(-bc[r] * LOG2E);
        LAS unsigned short* qp = (LAS unsigned short*)(L + GL_Q + t * 64 + kf * 2); LAS unsigned short* kp = (LAS unsigned short*)(L + GL_K + t * 64 + kf * 2);
        *qp = (unsigned short)f2bf(bf2f(*qp) * qscale * e); *kp = (unsigned short)f2bf(bf2f(*kp) * ei); }
    if (hi == 0) *(LAS float*)(L + GL_EB + kf * 4) = fast_exp2(tot * LOG2E);
    asm volatile("s_waitcnt lgkmcnt(0)" ::: "memory");
    return tot;
}
__device__ __forceinline__ void gla_state_update(f32x16 (&S)[2], const LAS unsigned char* L, int lane) {
    const int hi = lane >> 5, q4 = (lane & 15) >> 2, cb = 16 * ((lane >> 4) & 1), p4 = 4 * (lane & 3);
#pragma unroll
    for (int st = 0; st < 2; ++st) {
        const LAS unsigned char* ka = L + GL_K + (16 * st + 8 * hi + q4) * 64 + (cb + p4) * 2;
        const bf16x8 a = tr8(ka, ka + 4 * 64);
#pragma unroll
        for (int vt = 0; vt < 2; ++vt) { const LAS unsigned char* vb = L + GL_V + (16 * st + 8 * hi + q4) * 192 + (32 * vt + cb + p4) * 2;
            const bf16x8 bfr = tr8(vb, vb + 4 * 192);
            S[vt] = __builtin_amdgcn_mfma_f32_32x32x16_bf16(a, bfr, S[vt], 0, 0, 0); }
    }
#pragma unroll
    for (int r = 0; r < 16; ++r) { const float e = *(const LAS float*)(L + GL_EB + ((r & 3) + 8 * (r >> 2) + 4 * hi) * 4); S[0][r] *= e; S[1][r] *= e; }
}
__device__ __forceinline__ void gla_load_w(const GlaCtx& C, int h, int lane, float (&W)[8], float& bias) {
    const int kf = lane & 31, hi = lane >> 5;
#pragma unroll
    for (int s = 0; s < 8; ++s) W[s] = C.wglr[(2 * s + hi) * 128 + h * 32 + kf];
    bias = C.bglr[h * 32 + kf];
}
__device__ __forceinline__ void gla_pass_a(const GlaCtx& C, int task, LAS unsigned char* L, int lane) {
    const int seg = task & (GLA_NSEG - 1), bh = task / GLA_NSEG, b = bh >> 2, h = bh & 3;
    float W[8], bias; gla_load_w(C, h, lane, W, bias);
    f32x16 S[2]; S[0] = (f32x16){}; S[1] = (f32x16){};
    float dtot = 0.f;
#pragma unroll 1
    for (int c = 0; c < GLA_SEG; ++c) {
        const size_t row0 = (size_t)b * SEQ + (size_t)(seg * GLA_SEG + c) * 32;
        dtot += gla_prep_chunk(C, h, row0, W, bias, L, lane);
        gla_state_update(S, L, lane);
        asm volatile("s_waitcnt lgkmcnt(0)" ::: "memory");
    }
    float* ag = C.AGG + (size_t)task * GLA_AGG_STRIDE;
#pragma unroll
    for (int vt = 0; vt < 2; ++vt)
#pragma unroll
        for (int r = 0; r < 16; ++r) st_dev(ag + (vt * 16 + r) * 64 + lane, S[vt][r]);
    if (lane < 32) st_dev(ag + 2048 + lane, dtot);
}
__device__ __forceinline__ void gla_pass_c(const GlaCtx& C, int task, LAS unsigned char* L, int lane) {
    const int seg = task & (GLA_NSEG - 1), bh = task / GLA_NSEG, b = bh >> 2, h = bh & 3;
    const int r32 = lane & 31, hi = lane >> 5;
    float W[8], bias; gla_load_w(C, h, lane, W, bias);
    f32x16 S[2]; S[0] = (f32x16){}; S[1] = (f32x16){};
    { const float* sst = C.SST + (size_t)task * 2048;
#pragma unroll
      for (int r = 0; r < 16; ++r) { S[0][r] = ld_dev(sst + r * 64 + lane); S[1][r] = ld_dev(sst + (16 + r) * 64 + lane); } }
    f32x4 gnv[8];
#pragma unroll
    for (int q8 = 0; q8 < 8; ++q8) gnv[q8] = *(const f32x4*)(C.gnorm + h * 64 + 32 * (q8 >> 2) + 8 * (q8 & 3) + 4 * hi);
#pragma unroll 1
    for (int c = 0; c < GLA_SEG; ++c) {
        const size_t row0 = (size_t)b * SEQ + (size_t)(seg * GLA_SEG + c) * 32;
        const size_t row = row0 + r32;
        unsigned long long gwv[8];
#pragma unroll
        for (int q8 = 0; q8 < 8; ++q8) gwv[q8] = *(const unsigned long long*)(C.PROJ + row * NPROJ + PC_GO + h * 64 + 32 * (q8 >> 2) + 8 * (q8 & 3) + 4 * hi);
        (void)gla_prep_chunk(C, h, row0, W, bias, L, lane);
        f32x16 at = {};
#pragma unroll
        for (int st = 0; st < 2; ++st) { const bf16x8 a = *(const LAS bf16x8*)(L + GL_K + r32 * 64 + (16 * st + 8 * hi) * 2), bq = *(const LAS bf16x8*)(L + GL_Q + r32 * 64 + (16 * st + 8 * hi) * 2);
            at = __builtin_amdgcn_mfma_f32_32x32x16_bf16(a, bq, at, 0, 0, 0); }
#pragma unroll
        for (int r = 0; r < 16; ++r) { const int s = (r & 3) + 8 * (r >> 2) + 4 * hi; at[r] = (s <= r32) ? at[r] : 0.f; }
        const bf16x8 pa0 = pack8(at[0], at[1], at[2], at[3], at[4], at[5], at[6], at[7]), pa1 = pack8(at[8], at[9], at[10], at[11], at[12], at[13], at[14], at[15]);
        f32x16 oT[2];
        const int q4 = (lane & 15) >> 2, cb = 16 * ((lane >> 4) & 1), p4 = 4 * (lane & 3);
#pragma unroll
        for (int vt = 0; vt < 2; ++vt) {
            const LAS unsigned char* vb = L + GL_V + (4 * hi + q4) * 192 + (32 * vt + cb + p4) * 2;
            const bf16x8 a0 = tr8(vb, vb + 8 * 192), a1 = tr8(vb + 16 * 192, vb + 24 * 192);
            f32x16 acc = {};
            acc = __builtin_amdgcn_mfma_f32_32x32x16_bf16(a0, pa0, acc, 0, 0, 0);
            acc = __builtin_amdgcn_mfma_f32_32x32x16_bf16(a1, pa1, acc, 0, 0, 0);
#pragma unroll
            for (int st = 0; st < 2; ++st) {
                const bf16x8 sa = pack8(S[vt][8 * st], S[vt][8 * st + 1], S[vt][8 * st + 2], S[vt][8 * st + 3], S[vt][8 * st + 4], S[vt][8 * st + 5], S[vt][8 * st + 6], S[vt][8 * st + 7]);
                const LAS unsigned char* qb = L + GL_Q + r32 * 64 + (16 * st + 4 * hi) * 2;
                const unsigned long long lo = *(const LAS unsigned long long*)qb, hh = *(const LAS unsigned long long*)(qb + 16);
                v4u w; w.x = (unsigned)lo; w.y = (unsigned)(lo >> 32); w.z = (unsigned)hh; w.w = (unsigned)(hh >> 32);
                acc = __builtin_amdgcn_mfma_f32_32x32x16_bf16(sa, __builtin_bit_cast(bf16x8, w), acc, 0, 0, 0);
            }
            oT[vt] = acc;
        }
        gla_state_update(S, L, lane);
        float ssq = 0.f;
#pragma unroll
        for (int r = 0; r < 16; ++r) ssq += oT[0][r] * oT[0][r] + oT[1][r] * oT[1][r];
        ssq += __shfl_xor(ssq, 32);
        const float rn = 1.0f / sqrtf(ssq * (1.0f / 64.0f) + EPS);
#pragma unroll
        for (int vt = 0; vt < 2; ++vt)
#pragma unroll
            for (int g = 0; g < 4; ++g) { const int v0 = 32 * vt + 8 * g + 4 * hi;
                const unsigned long long gw = gwv[vt * 4 + g];
                const f32x4 gn = gnv[vt * 4 + g];
                const float g0 = bflo((unsigned)gw), g1 = bfhi((unsigned)gw), g2 = bflo((unsigned)(gw >> 32)), g3 = bfhi((unsigned)(gw >> 32));
                const float o0 = oT[vt][4 * g] * rn * gn[0] * (g0 * sigmoidf_(g0)), o1 = oT[vt][4 * g + 1] * rn * gn[1] * (g1 * sigmoidf_(g1));
                const float o2 = oT[vt][4 * g + 2] * rn * gn[2] * (g2 * sigmoidf_(g2)), o3 = oT[vt][4 * g + 3] * rn * gn[3] * (g3 * sigmoidf_(g3));
                *(unsigned long long*)(C.MIX + row * DM + 768 + h * 64 + v0) = (unsigned long long)pg8::cvt_pk_bf16(o0, o1) | ((unsigned long long)pg8::cvt_pk_bf16(o2, o3) << 32); }
        asm volatile("s_waitcnt lgkmcnt(0)" ::: "memory");
    }
}
__device__ __forceinline__ void gla_scan(Frame& F, int eg0, int egstride) {
    const float* AGG = (const float*)(F.ws + WS_GLAAGG); float* SST = (float*)(F.ws + WS_GLASST);
    for (int eg = eg0; eg < NB * 4 * 2048; eg += egstride) {
        const int bh = eg >> 11, e = eg & 2047, r = (e >> 6) & 15, ln = e & 63, k = (r & 3) + 8 * (r >> 2) + 4 * (ln >> 5);
        const float* ag = AGG + (size_t)bh * GLA_NSEG * GLA_AGG_STRIDE; float* st = SST + (size_t)bh * GLA_NSEG * 2048 + e;
        float S = 0.f;
#pragma unroll 1
        for (int j0 = 0; j0 < GLA_NSEG; j0 += 32) {
            float dv[32], ev[32];
#pragma unroll
            for (int j = 0; j < 32; ++j) { dv[j] = ld_dev(ag + (size_t)(j0 + j) * GLA_AGG_STRIDE + 2048 + k); ev[j] = ld_dev(ag + (size_t)(j0 + j) * GLA_AGG_STRIDE + e); }
            asm volatile("" : "+v"(dv[0]), "+v"(dv[1]), "+v"(dv[2]), "+v"(dv[3]), "+v"(dv[4]), "+v"(dv[5]), "+v"(dv[6]), "+v"(dv[7]), "+v"(dv[8]), "+v"(dv[9]), "+v"(dv[10]), "+v"(dv[11]), "+v"(dv[12]), "+v"(dv[13]), "+v"(dv[14]), "+v"(dv[15]), "+v"(dv[16]), "+v"(dv[17]), "+v"(dv[18]), "+v"(dv[19]), "+v"(dv[20]), "+v"(dv[21]), "+v"(dv[22]), "+v"(dv[23]), "+v"(dv[24]), "+v"(dv[25]), "+v"(dv[26]), "+v"(dv[27]), "+v"(dv[28]), "+v"(dv[29]), "+v"(dv[30]), "+v"(dv[31]));
            asm volatile("" : "+v"(ev[0]), "+v"(ev[1]), "+v"(ev[2]), "+v"(ev[3]), "+v"(ev[4]), "+v"(ev[5]), "+v"(ev[6]), "+v"(ev[7]), "+v"(ev[8]), "+v"(ev[9]), "+v"(ev[10]), "+v"(ev[11]), "+v"(ev[12]), "+v"(ev[13]), "+v"(ev[14]), "+v"(ev[15]), "+v"(ev[16]), "+v"(ev[17]), "+v"(ev[18]), "+v"(ev[19]), "+v"(ev[20]), "+v"(ev[21]), "+v"(ev[22]), "+v"(ev[23]), "+v"(ev[24]), "+v"(ev[25]), "+v"(ev[26]), "+v"(ev[27]), "+v"(ev[28]), "+v"(ev[29]), "+v"(ev[30]), "+v"(ev[31]));
#pragma unroll
            for (int j = 0; j < 32; ++j) { st_dev(st + (size_t)(j0 + j) * 2048, S); S = S * fast_exp2(dv[j] * LOG2E) + ev[j]; }
        }
    }
}
__device__ __forceinline__ void sub_barrier(unsigned* ctr, unsigned n, unsigned* bar, const bool leader_thread) {
    asm volatile("s_waitcnt vmcnt(0)" ::: "memory");
    __syncthreads();
    if (leader_thread) { (void)xb_add(ctr, 1u); XB_SPIN(xb_ld(ctr) < n, bar); }
    __syncthreads();
}
__device__ __forceinline__ void mix_phase(Frame& F, int layer, const bf16* PROJ, bf16* MIX) {
    const int bx = (int)blockIdx.x, ngb = F.G >= 8 ? F.G / 4 : 1;
    if (bx < ngb) {
        GlaCtx C{(const bf16*)(F.ws + WS_PROJ), (const float*)(F.ws + WS_GZ), F.in[I_WGLR] + layer * 16 * 128, F.in[I_BGLR] + layer * 128, F.in[I_GLANORM] + layer * 256, (bf16*)(F.ws + WS_MIX), (float*)(F.ws + WS_GLAAGG), (const float*)(F.ws + WS_GLASST)};
        LAS unsigned char* L = F.lds + RING_OFF + F.wave * GL_WAVE_BYTES;
        unsigned* bar = (unsigned*)(F.ctl + CW_BAR); unsigned* ctr = (unsigned*)(F.ctl + CW_GLAB) + layer * 128;
        for (int task = bx * NWAVES + F.wave; task < NB * 4 * GLA_NSEG; task += ngb * NWAVES) gla_pass_a(C, task, L, F.lane);
        sub_barrier(ctr, (unsigned)ngb, bar, F.tid == 0);
        if (F.wave < 4) gla_scan(F, (bx * 4 + F.wave) * 64 + F.lane, ngb * 256);
        sub_barrier(ctr + 64, (unsigned)ngb, bar, F.tid == 0);
        for (int task = bx * NWAVES + F.wave; task < NB * 4 * GLA_NSEG; task += ngb * NWAVES) gla_pass_c(C, task, L, F.lane);
    } else {
        const int na = F.G - ngb, avcu = (F.G % 8 == 0 && ngb % 8 == 0) ? (bx % 8) * (na / 8) + (bx - ngb) / 8 : bx - ngb;
        attn_phase(F, PROJ, avcu, na, F.in[I_CONVW] + layer * 3 * 256, MIX);
    }
}

__device__ __forceinline__ void router_phase(Frame& F) {
    const bf16* H = (const bf16*)(F.ws + WS_HB); const float* ss = ss_arr(F, 3); const bf16* RG = (const bf16*)(F.ws + WS_RG);
    int* TOKE = (int*)(F.ws + WS_TOKE); float* TOKW = (float*)(F.ws + WS_TOKW); int* BLKCNT = (int*)(F.ws + WS_BLKCNT);
    LAS int* lcnt = (LAS int*)(F.lds + RING_OFF);
    const int lane = F.lane, kh = F.wave >> 2;
    LAS f32x4* xch = (LAS f32x4*)(F.lds + RING_OFF + 1024) + (F.wave & 3) * 64 + lane;
    for (int grp = blockIdx.x; grp < T / 64; grp += F.G) {
        if (F.tid < 8) lcnt[F.tid] = 0;
        const int t0 = grp * 64 + (F.wave & 3) * 16;
        f32x4 acc = (f32x4){0.f, 0.f, 0.f, 0.f};
        {
            const bf16* ah = RG + (size_t)(lane & 15) * DM + 8 * (lane >> 4) + 512 * kh; const bf16* al = ah + 16 * DM;
            const bf16* bp = H + (size_t)(t0 + (lane & 15)) * DM + 8 * (lane >> 4) + 512 * kh;
#pragma unroll 1
            for (int s0 = 0; s0 < 16; s0 += 8) {
                bf16x8 a[8], a2[8], bv[8];
#pragma unroll
                for (int j = 0; j < 8; ++j) { a[j] = *(const bf16x8*)(ah + 32 * (s0 + j)); a2[j] = *(const bf16x8*)(al + 32 * (s0 + j)); bv[j] = *(const bf16x8*)(bp + 32 * (s0 + j)); }
                asm volatile("" : "+v"(a[0]), "+v"(a[1]), "+v"(a[2]), "+v"(a[3]), "+v"(a[4]), "+v"(a[5]), "+v"(a[6]), "+v"(a[7]), "+v"(a2[0]), "+v"(a2[1]), "+v"(a2[2]), "+v"(a2[3]), "+v"(a2[4]), "+v"(a2[5]), "+v"(a2[6]), "+v"(a2[7]),
                             "+v"(bv[0]), "+v"(bv[1]), "+v"(bv[2]), "+v"(bv[3]), "+v"(bv[4]), "+v"(bv[5]), "+v"(bv[6]), "+v"(bv[7]));
#pragma unroll
                for (int j = 0; j < 8; ++j) { acc = __builtin_amdgcn_mfma_f32_16x16x32_bf16(a[j], bv[j], acc, 0, 0, 0); acc = __builtin_amdgcn_mfma_f32_16x16x32_bf16(a2[j], bv[j], acc, 0, 0, 0); }
            }
        }
        if (kh) *xch = acc;
        __syncthreads();
        if (!kh) {
            acc += *xch;
            float lg[8];
#pragma unroll
            for (int r = 0; r < 4; ++r) { lg[r] = acc[r]; lg[4 + r] = __shfl(acc[r], (lane & 15) + 16); }
            const int t = t0 + (lane & 15);
            const float rstd = row_rstd(ss, t);
            float l0 = -3.0e38f, l1 = -3.0e38f; int i0 = 0, i1 = 0;
#pragma unroll
            for (int e = 0; e < 8; ++e) { const float v = lg[e] * rstd; if (v > l0) { l1 = l0; i1 = i0; l0 = v; i0 = e; } else if (v > l1) { l1 = v; i1 = e; } }
            const float ex = expf(l1 - l0), w0 = 1.0f / (1.0f + ex), w1 = ex * w0;
            if (lane < 16) { st_devi(TOKE + 2 * t, i0); st_devi(TOKE + 2 * t + 1, i1); st_dev(TOKW + 2 * t, w0); st_dev(TOKW + 2 * t + 1, w1); atomicAdd((int*)&lcnt[i0], 1); atomicAdd((int*)&lcnt[i1], 1); }
        }
        __syncthreads();
        if (F.tid < 8) st_devi(BLKCNT + grp * 8 + F.tid, lcnt[F.tid]);
        __syncthreads();
    }
}

__device__ __forceinline__ void dispatch_phase(Frame& F) {
    const int* BLKCNT = (const int*)(F.ws + WS_BLKCNT); const int* TOKE = (const int*)(F.ws + WS_TOKE); int* TOKS = (int*)(F.ws + WS_TOKS);
    float* SRSTD = (float*)(F.ws + WS_SRSTD); int* PANEL = (int*)(F.ws + WS_PANEL); const float* ss = ss_arr(F, 3);
    const bf16* HB = (const bf16*)(F.ws + WS_HB); unsigned char* ASORT = F.ws + WS_ASORT;
    LAS int* L = (LAS int*)(F.lds + RING_OFF);
    for (int grp = blockIdx.x; grp < T / 64; grp += F.G) {
        for (int i = F.tid; i < 2048; i += NWAVES * 64) L[i] = BLKCNT[i];
        const int my_e = (F.tid < 128) ? TOKE[(grp * 64) * 2 + F.tid] : 0;
        __syncthreads();
        if (F.tid < 256) { const int e = F.tid & 7, part = F.tid >> 3; int tot = 0, pre = 0;
#pragma unroll
            for (int q = 0; q < 8; ++q) { const int g = part * 8 + q, c = L[g * 8 + e]; tot += c; pre += (g < grp) ? c : 0; }
            L[2336 + F.tid] = tot; L[2592 + F.tid] = pre; }
        __syncthreads();
        if (F.tid < 8) { int tot = 0, pre = 0;
#pragma unroll
            for (int part = 0; part < 32; ++part) { tot += L[2336 + part * 8 + F.tid]; pre += L[2592 + part * 8 + F.tid]; }
            L[2048 + F.tid] = tot; L[2056 + F.tid] = pre; }
        int rank = 0;
        if (F.wave < 2) {
#pragma unroll
            for (int x = 0; x < 8; ++x) { const unsigned long long m = __ballot(my_e == x); if (my_e == x) rank = __popcll(m & ((1ull << F.lane) - 1ull)); if (F.wave == 0 && F.lane == x) L[2072 + x] = __popcll(m); }
        }
        __syncthreads();
        if (F.tid == 0) { int base = 0; for (int e = 0; e < 8; ++e) { L[2064 + e] = base; const int np = (L[2048 + e] + 255) >> 8;
                if (grp == 0) for (int p = 0; p < np; ++p) st_devi(PANEL + 8 + (base >> 8) + p, e);
                base += np << 8; }
            if (grp == 0) st_devi(PANEL, base >> 8); }
        __syncthreads();
        if (F.tid < 128) { const int a = F.tid, e = my_e; if (F.wave == 1) rank += L[2072 + e];
            const int slot = L[2064 + e] + L[2056 + e] + rank; const int t = grp * 64 + (a >> 1);
            st_devi(TOKS + 2 * t + (a & 1), slot); st_dev(SRSTD + slot, row_rstd(ss, t)); L[2208 + a] = slot; }
        if (grp == 0) { for (int e = 0; e < 8; ++e) { const int b0 = L[2064 + e] + L[2048 + e], b1 = L[2064 + e] + (((L[2048 + e] + 255) >> 8) << 8); for (int s = b0 + F.tid; s < b1; s += NWAVES * 64) st_dev(SRSTD + s, 0.f); } }
        __syncthreads();
        {
            v4u rv[16][2];
#pragma unroll
            for (int i = 0; i < 16; ++i) { const int a = F.wave + NWAVES * i; const v4u* src = (const v4u*)(HB + (size_t)(grp * 64 + (a >> 1)) * DM); rv[i][0] = src[2 * F.lane]; rv[i][1] = src[2 * F.lane + 1]; }
#pragma unroll
            for (int i = 0; i < 16; ++i) { const int a = F.wave + NWAVES * i; v4u* dst = (v4u*)(ASORT + (size_t)L[2208 + a] * DM);
                v4u o; o.x = pg8::pk4_fp8(bflo(rv[i][0].x), bfhi(rv[i][0].x), bflo(rv[i][0].y), bfhi(rv[i][0].y)); o.y = pg8::pk4_fp8(bflo(rv[i][0].z), bfhi(rv[i][0].z), bflo(rv[i][0].w), bfhi(rv[i][0].w));
                o.z = pg8::pk4_fp8(bflo(rv[i][1].x), bfhi(rv[i][1].x), bflo(rv[i][1].y), bfhi(rv[i][1].y)); o.w = pg8::pk4_fp8(bflo(rv[i][1].z), bfhi(rv[i][1].z), bflo(rv[i][1].w), bfhi(rv[i][1].w));
                st_wt16(dst + F.lane, o); } }
        __syncthreads();
    }
}
__device__ __forceinline__ void final_phase(Frame& F) {
    const int lane = F.lane, wv = F.wave;
    const int gw = F.vcu * NWAVES + wv, NGW = F.G * NWAVES;
    const int* TOKS = (const int*)(F.ws + WS_TOKS); const float* TOKW = (const float*)(F.ws + WS_TOKW); const bf16* Y = (const bf16*)(F.ws + WS_Y);
    f32x4 gn[4];
#pragma unroll
    for (int j = 0; j < 4; ++j) gn[j] = *((const f32x4*)F.in[I_FINALNORM] + lane + 64 * j);
    for (int t0 = gw; t0 < T; t0 += 2 * NGW) {
        int tt[2], sl[2][2]; float wt[2][2];
#pragma unroll
        for (int k = 0; k < 2; ++k) { tt[k] = (t0 + k * NGW < T) ? t0 + k * NGW : t0; sl[k][0] = TOKS[2 * tt[k]]; sl[k][1] = TOKS[2 * tt[k] + 1]; wt[k][0] = TOKW[2 * tt[k]]; wt[k][1] = TOKW[2 * tt[k] + 1]; }
        unsigned long long hw[2][4], ya[2][4], yb[2][4];
#pragma unroll
        for (int k = 0; k < 2; ++k) {
            const GAS unsigned long long* hr = (const GAS unsigned long long*)((const bf16*)(F.ws + WS_HB) + (size_t)tt[k] * DM) + lane;
            const GAS unsigned long long* y0 = (const GAS unsigned long long*)(Y + (size_t)(sl[k][0] >= MOE_TAIL_ROW0 ? 0 : sl[k][0]) * DM) + lane;
            const GAS unsigned long long* y1 = (const GAS unsigned long long*)(Y + (size_t)(sl[k][1] >= MOE_TAIL_ROW0 ? 0 : sl[k][1]) * DM) + lane;
#pragma unroll
            for (int j = 0; j < 4; ++j) { hw[k][j] = __builtin_nontemporal_load(hr + 64 * j); ya[k][j] = __builtin_nontemporal_load(y0 + 64 * j); yb[k][j] = __builtin_nontemporal_load(y1 + 64 * j); }
        }
        asm volatile("" : "+v"(hw[0][0]), "+v"(hw[0][1]), "+v"(hw[0][2]), "+v"(hw[0][3]), "+v"(ya[0][0]), "+v"(ya[0][1]), "+v"(ya[0][2]), "+v"(ya[0][3]), "+v"(yb[0][0]), "+v"(yb[0][1]), "+v"(yb[0][2]), "+v"(yb[0][3]),
                     "+v"(hw[1][0]), "+v"(hw[1][1]), "+v"(hw[1][2]), "+v"(hw[1][3]), "+v"(ya[1][0]), "+v"(ya[1][1]), "+v"(ya[1][2]), "+v"(ya[1][3]), "+v"(yb[1][0]), "+v"(yb[1][1]), "+v"(yb[1][2]), "+v"(yb[1][3]));
#pragma unroll
        for (int k = 0; k < 2; ++k) {
            if (k == 1 && t0 + NGW >= T) break;
            const int t = tt[k]; const int s0 = sl[k][0], s1 = sl[k][1]; const float w0 = wt[k][0], w1 = wt[k][1];
            const float w0e = (s0 >= MOE_TAIL_ROW0) ? 0.f : w0, w1e = (s1 >= MOE_TAIL_ROW0) ? 0.f : w1;
            GAS f32x4* xr = (GAS f32x4*)(F.out + (size_t)t * DM) + lane;
            f32x4 v[4]; float s = 0.f;
#pragma unroll
            for (int j = 0; j < 4; ++j) { const unsigned long long h_ = hw[k][j], a = ya[k][j], b = yb[k][j];
                v[j].x = bflo((unsigned)h_) + w0e * bflo((unsigned)a) + w1e * bflo((unsigned)b); v[j].y = bfhi((unsigned)h_) + w0e * bfhi((unsigned)a) + w1e * bfhi((unsigned)b);
                v[j].z = bflo((unsigned)(h_ >> 32)) + w0e * bflo((unsigned)(a >> 32)) + w1e * bflo((unsigned)(b >> 32)); v[j].w = bfhi((unsigned)(h_ >> 32)) + w0e * bfhi((unsigned)(a >> 32)) + w1e * bfhi((unsigned)(b >> 32)); }
#pragma unroll 1
            for (int q = 0; q < 2; ++q) { const int sq = q ? s1 : s0; const float wk = q ? w1 : w0; if (sq < MOE_TAIL_ROW0) continue;
                const GAS unsigned long long* yp = (const GAS unsigned long long*)((const bf16*)(F.ws + WS_YP) + (size_t)(sq - MOE_TAIL_ROW0) * DM) + lane;
                f32x4 acc4[4];
#pragma unroll
                for (int j = 0; j < 4; ++j) acc4[j] = (f32x4){0.f, 0.f, 0.f, 0.f};
#pragma unroll
                for (int p = 0; p < MOE_TAIL_P; ++p)
#pragma unroll
                    for (int j = 0; j < 4; ++j) { const unsigned long long a = yp[(size_t)p * (MOE_TAIL_ROWS * DM / 4) + 64 * j];
                        acc4[j].x += bflo((unsigned)a); acc4[j].y += bfhi((unsigned)a); acc4[j].z += bflo((unsigned)(a >> 32)); acc4[j].w += bfhi((unsigned)(a >> 32)); }
#pragma unroll
                for (int j = 0; j < 4; ++j) v[j] += wk * acc4[j]; }
#pragma unroll
            for (int j = 0; j < 4; ++j) s += (v[j].x * v[j].x + v[j].y * v[j].y) + (v[j].z * v[j].z + v[j].w * v[j].w);
            s = wave_sum(s);
            const float rstd = 1.0f / sqrtf(s * (1.0f / DM) + EPS);
#pragma unroll
            for (int j = 0; j < 4; ++j) xr[64 * j] = v[j] * rstd * gn[j];
        }
    }
}

__device__ __forceinline__ int fresh(Frame& F) { int l_; asm volatile("v_mbcnt_lo_u32_b32 %0, -1, 0\n\tv_mbcnt_hi_u32_b32 %0, -1, %0" : "=v"(l_)); F.lane = l_; F.tid = F.wave * 64 + l_; return 0; }
struct Args { const float* in[17]; float* out; unsigned char* ws; int ph_lo, ph_hi; };
constexpr int N_PHASES = 20;
#ifndef SK_UP
#define SK_UP 0
#endif

#ifndef MK_ONE_LAUNCH
#define MK_ONE_LAUNCH 1
#endif

__global__ void __launch_bounds__(NWAVES * 64, 2) mega_fwd(Args args) {
    extern __shared__ __attribute__((aligned(16))) unsigned char lds[];
    Frame F;
    F.lds = (LAS unsigned char*)lds;
    F.MISC = (volatile LAS unsigned*)(F.lds + MISC_OFF);
    F.tid = threadIdx.x; F.lane = F.tid & 63; F.wave = __builtin_amdgcn_readfirstlane(F.tid >> 6);
    F.G = gridDim.x; { const int bx = blockIdx.x; F.vcu = (F.G % 8 == 0) ? (bx % 8) * (F.G / 8) + bx / 8 : bx; }
    F.ws = args.ws; F.ctl = (gu32*)(args.ws + WS_CTL); F.out = args.out;
#pragma unroll
    for (int i = 0; i < 17; ++i) F.in[i] = args.in[i];
    for (int u = F.tid; u < (LDS_BYTES - LDSCTL_OFF) / 4; u += NWAVES * 64) ((LAS unsigned*)(F.lds + LDSCTL_OFF))[u] = 0u;
    __syncthreads();
    XcdBarrier bar; bar.bar = (unsigned*)(F.ctl + CW_BAR); bar.x = 0; bar.st = nullptr;
    if (MK_ONE_LAUNCH) bar = xcd_barrier_post((unsigned*)(F.ctl + CW_BAR), F.MISC + 8);
    const int lo = args.ph_lo, hi = args.ph_hi;
#define TS(id) do { if (PROBE_T == (id) && blockIdx.x == 0 && F.wave == ((PROBE_T >= 1000) ? 2 : 0)) { const unsigned t_ = (unsigned)__builtin_amdgcn_s_memrealtime(); ((volatile LAS unsigned*)(F.lds + LDSCTL_OFF))[16] = t_; } } while (0)
#define TE(id) do { if (PROBE_T == (id) && blockIdx.x == 0 && F.wave == ((PROBE_T >= 1000) ? 2 : 0)) { volatile LAS unsigned* w_ = (volatile LAS unsigned*)(F.lds + LDSCTL_OFF); const unsigned t_ = (unsigned)__builtin_amdgcn_s_memrealtime(); w_[17] = w_[17] + (t_ - w_[16]); } } while (0)
#define IN(k) (lo <= (k) && (k) < hi)
#define REPS(k) for (int rep_ = fresh(F); rep_ < ((PROBE_REP == (k)) ? 2 : 1); ++rep_, ((PROBE_REP == (k)) && rep_ < 2 ? (fresh(F), xcd_barrier(bar, F.tid == 0)) : (void)0))
#define SEAM(k) do { if (IN(k) && IN((k) + 1)) { fresh(F); xcd_barrier(bar, F.tid == 0); } TE(k); TS((k) + 1); } while (0)
#define SEAM_FLAT(k, n) do { if (IN(k) && IN((k) + 1)) { fresh(F); if (lo == 0 && hi == N_PHASES && F.G % 64 == 0) flat_barrier((unsigned*)(F.ctl + CW_FLAT), (unsigned)(n) * (unsigned)(F.G / 64), (unsigned*)(F.ctl + CW_BAR), F.wave, F.lane, (int)blockIdx.x); else xcd_barrier(bar, F.tid == 0); } TE(k); TS((k) + 1); } while (0)

    bf16* HB = (bf16*)(F.ws + WS_HB); bf16* PROJ = (bf16*)(F.ws + WS_PROJ); bf16* MIX = (bf16*)(F.ws + WS_MIX);

    TS(0);
    if (IN(0)) { REPS(0) p0_prologue(F); } SEAM(0);

#define HANDOFF_OK(pb) (IN((pb) + 3) && IN((pb) + 4) && F.G == (T / 256) * (DM / 256))
#define MIXER_LAYER(l, pb, nflat) do { \
        if (IN(pb)) REPS(pb) { \
            pg8::Gemm g{HB, (const bf16*)(F.ws + WS_WIN) + (size_t)(l) * NPROJ * DM, T, NPROJ, DM}; pg8::StaticOrder S; S.init(T, NPROJ, F.G, (int)blockIdx.x); TS(140 + (pb)); rstd_cache_fill(F, S, ss_arr(F, 2 * (l))); TE(140 + (pb)); TS(150 + (pb)); \
            pg8::EpiProj E{PROJ, (const LAS float*)(F.lds + RSTD_CACHE_OFF), (const float*)(F.ws + WS_ROPE)}; \
            pg8::gemm_phase<pg8::EpiProj, pg8::StaticOrder, true, true>(F.lds + RING_OFF, g, S, E); TE(150 + (pb)); TS(160 + (pb)); \
            gz_phase(F, HB, (const bf16*)(F.ws + WS_WGZ) + (size_t)(l) * 16 * DM, ss_arr(F, 2 * (l)), (float*)(F.ws + WS_GZ)); TE(160 + (pb)); \
        } \
        SEAM_FLAT(pb, nflat); \
        if (IN(pb + 1)) { fresh(F); mix_phase(F, (l), PROJ, MIX); } \
        SEAM(pb + 1); \
          \
          \
        { \
          if (IN(pb + 3)) { fresh(F); \
            if (HANDOFF_OK(pb)) { pg8::StaticOrder S0; S0.init(T, DM, F.G, (int)blockIdx.x); int pm0, pn0; S0.first_tile(pm0, pn0); \
                attn_merge_rows(F, pm0 * 256 + (pn0 & 3) * 64, 64, MIX); \
                asm volatile("s_waitcnt vmcnt(0)" ::: "memory"); __syncthreads(); \
                if (F.tid == 0) { unsigned* pc_ = (unsigned*)(F.ctl + CW_PAN) + ((l) * 64 + pm0) * 16; (void)xb_add(pc_, 1u); XB_SPIN(xb_ld(pc_) < 4u, (unsigned*)(F.ctl + CW_BAR)); \
                    __builtin_amdgcn_fence(__ATOMIC_ACQUIRE, "agent"); asm volatile("s_waitcnt vmcnt(0)" ::: "memory"); } \
                __syncthreads(); } \
            else attn_merge(F, F.vcu * (NWAVES * 64) + F.tid, F.G * (NWAVES * 64), MIX); } \
          TE(pb + 2); TS(pb + 3); if (!HANDOFF_OK(pb)) SEAM(pb + 3); else { TE(pb + 3); TS(pb + 4); } } \
        if (IN(pb + 4)) { fresh(F); \
            pg8::Gemm g{MIX, (const bf16*)(F.ws + WS_WOUT) + (size_t)(l) * DM * DM, T, DM, DM}; pg8::StaticOrder S; S.init(T, DM, F.G, (int)blockIdx.x); \
            pg8::EpiResid E{HB, ss_arr(F, 2 * (l) + 1)}; \
            pg8::gemm_phase<pg8::EpiResid, pg8::StaticOrder, true, true>(F.lds + RING_OFF, g, S, E); \
        } \
        SEAM(pb + 4); } while (0)

    MIXER_LAYER(0, 1, 1);
    if (IN(6)) REPS(6) {
        pg8::Gemm g{HB, (const bf16*)(F.ws + WS_WGU), T, 2 * FFD, DM};
        if (SK_UP) { LAS int* sktab = (LAS int*)(F.lds + pg8::SK_TAB_OFF);
            pg8::sk_build(sktab, pg8::DenseMap{T / 256, 2 * FFD / 256}, (T / 256) * (2 * FFD / 256), DM / 128, F.G, (int)blockIdx.x, (float*)(F.ws + WS_SKP_FFN), (float*)(F.ws + WS_SKP_FFN), 1 << 20, (unsigned*)(F.ctl + CW_SKF), F.tid == 0);
            pg8::TabOrder S(sktab); pg8::EpiSK<pg8::EpiSwiglu> E{pg8::EpiSwiglu{(bf16*)(F.ws + WS_ACT), FFD_PITCH, nullptr, nullptr, 0, 22}, S.taddr, (unsigned*)(F.ctl + CW_TMO)};
            pg8::gemm_phase<pg8::EpiSK<pg8::EpiSwiglu>, pg8::TabOrder, true, true>(F.lds + RING_OFF, g, S, E);
        } else { pg8::StaticOrder S; S.init(T, 2 * FFD, F.G, (int)blockIdx.x); rstd_cache_fill(F, S, ss_arr(F, 1)); pg8::EpiSwiglu E{(bf16*)(F.ws + WS_ACT), FFD_PITCH, (const LAS float*)(F.lds + RSTD_CACHE_OFF), nullptr, 0, 22};
            pg8::gemm_phase<pg8::EpiSwiglu, pg8::StaticOrder, true, true>(F.lds + RING_OFF, g, S, E); }
    }
    SEAM_FLAT(6, 2);
    if (IN(7)) {
        fresh(F);
        pg8::Gemm g{(const bf16*)(F.ws + WS_ACT), (const bf16*)(F.ws + WS_WD), T, DM, FFD}; pg8::StaticOrder S; S.init(T, DM, F.G, (int)blockIdx.x);
        pg8::EpiResid E{HB, ss_arr(F, 2)};
        pg8::gemm_phase<pg8::EpiResid, pg8::StaticOrder, true, true, FFD_PITCH>(F.lds + RING_OFF, g, S, E);
    }
    SEAM(7);
    MIXER_LAYER(1, 8, 3);
    if (IN(13)) REPS(13) { router_phase(F); } SEAM_FLAT(13, 4);
    if (IN(14)) REPS(14) { dispatch_phase(F); } SEAM_FLAT(14, 5);
    {
        const int* PANEL = (const int*)(F.ws + WS_PANEL); LAS int* sktab = (LAS int*)(F.lds + pg8::SK_TAB_OFF);
        if (IN(15)) REPS(15) {
            const int np = PANEL[0];
            pg8::sk_build(sktab, pg8::MoeMap{np, 28, 0, PANEL + 8}, np * 28, 0, F.G, (int)blockIdx.x, F.out, F.out, 1 << 20, (unsigned*)(F.ctl + CW_SKF), F.tid == 0);
            pg8::Gemm g{(const bf16*)(F.ws + WS_ASORT), (const bf16*)(F.ws + WS_EGU), 0, 0, DM}; pg8::TabOrder S(sktab);
            pg8::EpiSwiglu8 E{F.ws + WS_EACT, FFE_PITCH, (const float*)(F.ws + WS_SRSTD), 0, 28};
            pg8::gemm_phase8<pg8::EpiSwiglu8, pg8::TabOrder, true, true>(F.lds + RING_OFF, g, S, E, F.wave);
        }
        SEAM(15);
        if (IN(16)) REPS(16) {
            const int np = PANEL[0], U = np * 4, Um = U < 512 ? U : 512;
            const pg8::MoeMap MM{np, 4, 0, PANEL + 8};
            pg8::sk_build(sktab, MM, Um, 0, F.G, (int)blockIdx.x, F.out, F.out, 1 << 20, (unsigned*)(F.ctl + CW_SKF + 4096), F.tid == 0);
            if (F.tid == 0) { for (int gp = (int)blockIdx.x; gp < (U - Um) * MOE_TAIL_P && sktab[-16] < pg8::SK_TAB_MAX; gp += F.G) { const int n_ = sktab[-16]; pg8::Unit u_; MM.map(Um + gp / MOE_TAIL_P, u_); const int part = gp % MOE_TAIL_P;
                LAS int* t_ = sktab + 16 * n_; t_[0] = u_.pm; t_[1] = u_.pn; t_[2] = part * (FFE / 128 / MOE_TAIL_P); t_[3] = FFE / 128 / MOE_TAIL_P; t_[4] = 1 + part; sktab[-16] = n_ + 1; } }
            __syncthreads();
            pg8::Gemm g{(const bf16*)(F.ws + WS_EACT), (const bf16*)(F.ws + WS_ED), 0, 0, FFE}; pg8::TabOrder S(sktab);
            pg8::EpiMoeDown E{(bf16*)(F.ws + WS_Y), 1.0f / W8_DN, (bf16*)(F.ws + WS_YP)};
            pg8::gemm_phase8<pg8::EpiMoeDown, pg8::TabOrder, true, true, FFE_PITCH>(F.lds + RING_OFF, g, S, E, F.wave);
        }
        SEAM(18); TE(16);
    }
    if (IN(19)) { fresh(F); final_phase(F); }
    TE(19);
    if (PROBE_T != -1 && blockIdx.x == 0) { __syncthreads(); if (F.wave == 0) { const unsigned acc_ = ((volatile LAS unsigned*)(F.lds + LDSCTL_OFF))[17]; const unsigned long long t0_ = __builtin_amdgcn_s_memrealtime(); while (__builtin_amdgcn_s_memrealtime() - t0_ < 8ull * acc_) __builtin_amdgcn_s_sleep(8); } }
#undef IN
#undef SEAM
}

extern "C" void kernel_launch(void* const* d_in, const int* in_sizes, int n_in, void* d_out, int out_size, void* d_ws, size_t ws_size, hipStream_t stream) {
    static int grid = 0;
    if (grid == 0) {
        if (n_in != 17 || out_size != T * DM || ws_size < WS_END) { fprintf(stderr, "kernel_launch: unexpected shapes (n_in %d, out %d, ws %zu)\n", n_in, out_size, ws_size); grid = -1; return; }
        int dev = 0, cus = 0;
        if (hipGetDevice(&dev) != hipSuccess || hipDeviceGetAttribute(&cus, hipDeviceAttributeMultiprocessorCount, dev) != hipSuccess) { grid = -1; return; }
        if (hipFuncSetAttribute((const void*)mega_fwd, hipFuncAttributeMaxDynamicSharedMemorySize, LDS_BYTES) != hipSuccess) { grid = -1; return; }
        (void)hipGetLastError();
        grid = cus;
    }
    if (grid < 0) return;
    (void)hipMemsetAsync((char*)d_ws + WS_CTL, 0, CTL_ZERO_BYTES, stream);
    Args a{};
    for (int i = 0; i < 17; ++i) a.in[i] = (const float*)d_in[i];
    a.out = (float*)d_out; a.ws = (unsigned char*)d_ws;
#if MK_ONE_LAUNCH
    a.ph_lo = 0; a.ph_hi = N_PHASES;
    hipLaunchKernelGGL(mega_fwd, dim3(grid), dim3(NWAVES * 64), LDS_BYTES, stream, a);
#else
    for (int p = 0; p < N_PHASES; ++p) {
        a.ph_lo = p; a.ph_hi = p + 1; hipLaunchKernelGGL(mega_fwd, dim3(grid), dim3(NWAVES * 64), LDS_BYTES, stream, a); }
#endif
}
```
